# Optimizing an MI355X kernel written in HIP

```python
import jax, jax.numpy as jnp
from jax import lax
import numpy as np

D_MODEL = 1024
BATCH = 4
SEQ = 8192
DEPTH = 1

GRID_W = 64
D_MIX = D_MODEL
D_CONV = D_MIX // 2
D_ATTN = D_MIX - D_CONV
HEAD_DIM = 64
N_HEADS = D_ATTN // HEAD_DIM
CONV_WIDTH = 31
NA_ROWS = 8
NA_COLS = 16
D_FF = -(-8 * D_MODEL // (3 * 256)) * 256
D_IN = 2 * D_CONV + 3 * D_ATTN
EPS = 1e-6

kernel_name = "hybrid_conformer_conv_neighbourhood_attn_block"


def rms_norm(x, g):
    xf = x.astype(jnp.float32)
    y = xf * lax.rsqrt(jnp.mean(xf * xf, axis=-1, keepdims=True) + EPS)
    return (y * g.astype(jnp.float32)).astype(x.dtype)


def layer_norm(x, g, b):
    xf = x.astype(jnp.float32)
    mu = jnp.mean(xf, axis=-1, keepdims=True)
    xc = xf - mu
    y = xc * lax.rsqrt(jnp.mean(xc * xc, axis=-1, keepdims=True) + EPS)
    return (y * g.astype(jnp.float32) + b.astype(jnp.float32)).astype(x.dtype)


def conformer_conv(a, gate, dw_kernel, dw_bias, ln_g, ln_b):
    u = a * jax.nn.sigmoid(gate)
    pad = CONV_WIDTH // 2
    y = lax.conv_general_dilated(
        u, dw_kernel[:, None, :], window_strides=(1,), padding=[(pad, pad)],
        dimension_numbers=("NWC", "WIO", "NWC"), feature_group_count=u.shape[-1])
    y = y + dw_bias
    y = layer_norm(y, ln_g, ln_b)
    return jax.nn.silu(y)


def neighbourhood_attention(q, k, v, rpb):
    B, S, H, Dh = q.shape
    rows = S // GRID_W
    kh = min(NA_ROWS, rows)
    kw = NA_COLS
    qg = q.reshape(B, rows, GRID_W, H, Dh)
    kg = k.reshape(B, rows, GRID_W, H, Dh)
    vg = v.reshape(B, rows, GRID_W, H, Dh)
    cols = jnp.arange(GRID_W)
    col_start = jnp.clip(cols - kw // 2, 0, GRID_W - kw)
    col_idx = col_start[:, None] + jnp.arange(kw)[None, :]
    col_bias_idx = col_idx - cols[:, None] + (NA_COLS - 1)
    scale = Dh ** -0.5

    def row_block(r):
        row_start = jnp.clip(r - kh // 2, 0, rows - kh)
        q_r = lax.dynamic_index_in_dim(qg, r, axis=1, keepdims=False)
        k_rows = lax.dynamic_slice_in_dim(kg, row_start, kh, axis=1)
        v_rows = lax.dynamic_slice_in_dim(vg, row_start, kh, axis=1)
        k_win = k_rows[:, :, col_idx]
        v_win = v_rows[:, :, col_idx]
        s = jnp.einsum("bqhd,brqchd->bhqrc", q_r, k_win,
                       preferred_element_type=jnp.float32) * scale
        row_bias_idx = row_start + jnp.arange(kh) - r + (NA_ROWS - 1)
        bias = rpb[:, row_bias_idx][:, :, col_bias_idx]
        s = s + jnp.transpose(bias, (0, 2, 1, 3))[None].astype(jnp.float32)
        p = jax.nn.softmax(s, axis=(-2, -1))
        return jnp.einsum("bhqrc,brqchd->bqhd", p.astype(v_win.dtype), v_win)

    out = lax.map(row_block, jnp.arange(rows))
    return jnp.moveaxis(out, 0, 1).reshape(B, S, H * Dh)


def setup_inputs(seed: int = 0) -> dict:
    key = jax.random.key(seed)
    ks = jax.random.split(key, 16)
    f32 = jnp.float32
    n = lambda k, shape, s: (jax.random.normal(k, shape, f32) * s).astype(f32)
    return {
        "x": n(ks[0], (BATCH, SEQ, D_MODEL), 1.0),
        "norm1_g": 1.0 + n(ks[1], (DEPTH, D_MODEL), 0.02),
        "w_in": n(ks[2], (DEPTH, D_MODEL, D_IN), D_MODEL ** -0.5),
        "q_norm_g": 1.0 + n(ks[3], (DEPTH, HEAD_DIM), 0.02),
        "k_norm_g": 1.0 + n(ks[4], (DEPTH, HEAD_DIM), 0.02),
        "rpb": n(ks[5], (DEPTH, N_HEADS, 2 * NA_ROWS - 1, 2 * NA_COLS - 1), 0.1),
        "dw_kernel": n(ks[6], (DEPTH, CONV_WIDTH, D_CONV), CONV_WIDTH ** -0.5),
        "dw_bias": n(ks[7], (DEPTH, D_CONV), 0.02),
        "conv_ln_g": 1.0 + n(ks[8], (DEPTH, D_CONV), 0.02),
        "conv_ln_b": n(ks[9], (DEPTH, D_CONV), 0.02),
        "w_out": n(ks[10], (DEPTH, D_MIX, D_MODEL), D_MIX ** -0.5),
        "norm2_g": 1.0 + n(ks[11], (DEPTH, D_MODEL), 0.02),
        "w_gate": n(ks[12], (DEPTH, D_MODEL, D_FF), D_MODEL ** -0.5),
        "w_up": n(ks[13], (DEPTH, D_MODEL, D_FF), D_MODEL ** -0.5),
        "w_down": n(ks[14], (DEPTH, D_FF, D_MODEL), D_FF ** -0.5),
    }


def reference(x, norm1_g, w_in, q_norm_g, k_norm_g, rpb, dw_kernel, dw_bias,
              conv_ln_g, conv_ln_b, w_out, norm2_g, w_gate, w_up, w_down):
    B, S, _ = x.shape
    splits = [D_CONV, 2 * D_CONV, 2 * D_CONV + D_ATTN, 2 * D_CONV + 2 * D_ATTN]
    for l in range(DEPTH):
        h = rms_norm(x, norm1_g[l])
        z = h @ w_in[l]
        a, gate, q, k, v = jnp.split(z, splits, axis=-1)
        conv_out = conformer_conv(a, gate, dw_kernel[l], dw_bias[l],
                                  conv_ln_g[l], conv_ln_b[l])
        q = rms_norm(q.reshape(B, S, N_HEADS, HEAD_DIM), q_norm_g[l])
        k = rms_norm(k.reshape(B, S, N_HEADS, HEAD_DIM), k_norm_g[l])
        v = v.reshape(B, S, N_HEADS, HEAD_DIM)
        attn_out = neighbourhood_attention(q, k, v, rpb[l])
        mix = jnp.concatenate([conv_out, attn_out], axis=-1)
        x = x + mix @ w_out[l]
        h = rms_norm(x, norm2_g[l])
        x = x + (jax.nn.silu(h @ w_gate[l]) * (h @ w_up[l])) @ w_down[l]
    return x
```

```cpp
#include <hip/hip_runtime.h>
#include <hip/hip_cooperative_groups.h>
#include <cstdio>
namespace cg = cooperative_groups;
#define N_LAUNCHES 1
namespace pg8 {
#define PG8_LAS __attribute__((address_space(3)))
typedef unsigned short bf16_t;
typedef short bf16x8 __attribute__((ext_vector_type(8)));
typedef float f32x4 __attribute__((ext_vector_type(4)));
typedef unsigned u32x4 __attribute__((ext_vector_type(4)));
constexpr int BM = 256, BK = 64, HALF = 128, HTB = HALF * BK * 2  , STAGE_BYTES = 8 * HTB, NXCD = 8, WGM = 8;

__host__ __device__ __forceinline__ int lds_byte(int r, int c) { const int st = (r >> 4) * 2 + (c >> 5), rr = r & 15, cc = c & 31, ob = rr * 64 + cc * 2; return st * 1024 + (ob ^ (((ob >> 9) & 1) << 5)); }
__host__ __device__ __forceinline__ void stage_rc(int b, int& R, int& C) { const int st = b / 1024, sb = b % 1024, swz = sb ^ (((sb >> 9) & 1) << 5); R = (st >> 1) * 16 + swz / 64; C = (st & 1) * 32 + (swz % 64) / 2; }
__host__ __device__ __forceinline__ int perm32(int rho) { const int n = rho >> 4, i = rho & 15; return 8 * (i >> 2) + 4 * n + (i & 3); }

struct Unit { int pm, pn; };
struct Gemm { const bf16_t* A; const bf16_t* Bt; int M, N, K; };

struct StaticOrder {
    int nM, nN, nwg, G, c;
    __host__ __device__ void init(int M, int N, int G_, int c_) { nM = M / BM; nN = N / BM; nwg = nM * nN; G = G_; c = c_; }
    __host__ __device__ bool next(int i, Unit& u) const {
        const long L = (long)i * G + c; if (L >= nwg) return false;
        int wgid = (int)L; { const int q = nwg / NXCD, r = nwg % NXCD, xcd = wgid % NXCD, off = wgid / NXCD; wgid = (xcd < r ? xcd * (q + 1) : r * (q + 1) + (xcd - r) * q) + off; }
        const int nig = WGM * nN, gid = wgid / nig, fm = gid * WGM, gsz = (nM - fm) < WGM ? (nM - fm) : WGM;
        u.pm = fm + ((wgid % nig) % gsz); u.pn = (wgid % nig) / gsz; return true;
    }
    __device__ __forceinline__ void a_ready(const Unit&) const {}
    __device__ __forceinline__ void done(const Unit&) const {}
};
__device__ __forceinline__ unsigned cvt_pk_bf16(float lo, float hi) { unsigned r; asm volatile("v_cvt_pk_bf16_f32 %0, %1, %2" : "=v"(r) : "v"(lo), "v"(hi)); return r; }
template <class Epi, class Sched, bool STAMP = false>
__device__ __forceinline__ void gemm_phase(PG8_LAS unsigned char* lds, const Gemm g, const Sched& S, const Epi& E, unsigned long long* stamps) {
    const int tid = threadIdx.x, wid = __builtin_amdgcn_readfirstlane(tid >> 6), lane = tid & 63, wr = wid >> 2, wc = wid & 3, fr = lane & 15, fq = lane >> 4;
    const int K = g.K, nt = K / BK;
    int ts_lo = 0, ts_hi = 0, nts = 0; const unsigned long long rt_entry = STAMP ? (unsigned long long)wall_clock64() : 0ull;
#define PG8_STAMP() do { if (STAMP && wid == 0 && nts < 64) { const unsigned long long _c = (unsigned long long)clock64(); \
        ts_lo = (lane == nts) ? (int)(unsigned)_c : ts_lo; ts_hi = (lane == nts) ? (int)(unsigned)(_c >> 32) : ts_hi; ++nts; } } while (0)
    PG8_STAMP();
    unsigned voffA[2], voffB[2];
#pragma unroll
    for (int i = 0; i < 2; ++i) { int R, C; stage_rc(tid * 16 + i * 8192, R, C); const int Rb = Epi::PERM ? ((R & ~31) + perm32(R & 31)) : R;
        voffA[i] = (unsigned)(R * K + C) * 2u; voffB[i] = (unsigned)(Rb * K + C) * 2u; }
    const size_t kstep = (size_t)(BK * 2);
    const size_t hstep = (size_t)HALF * K * 2;
    const size_t tstep = 2 * hstep;
    const unsigned ldsw = (unsigned)wid * 1024u;
    const int aoff = lds_byte(wr * 64 + fr, fq * 8), boff = lds_byte(wc * 32 + fr, fq * 8);
#define PG8_SA(b, h) (((b) * 2 + (h)) * HTB)
#define PG8_SB(b, h) ((4 + (b) * 2 + (h)) * HTB)
#define PG8_STAGE(bufoff, gbase, voff) do { _Pragma("unroll") for (int _i = 0; _i < 2; ++_i) \
        __builtin_amdgcn_global_load_lds((const unsigned*)((const char*)(gbase) + (voff)[_i]), (PG8_LAS unsigned*)(lds + (bufoff) + ldsw + _i * 8192), 16, 0, 0); } while (0)
#define PG8_LDA(dst, b, h) do { _Pragma("unroll") for (int m = 0; m < 4; ++m) _Pragma("unroll") for (int k = 0; k < 2; ++k) dst[m][k] = *(const PG8_LAS bf16x8*)(lds + PG8_SA(b, h) + aoff + m * 2048 + k * 1024); } while (0)
#define PG8_LDB(dst, b, h) do { _Pragma("unroll") for (int n = 0; n < 2; ++n) _Pragma("unroll") for (int k = 0; k < 2; ++k) dst[n][k] = *(const PG8_LAS bf16x8*)(lds + PG8_SB(b, h) + boff + n * 2048 + k * 1024); } while (0)
#define PG8_MMA(ai, bj, At, Bt) do { __builtin_amdgcn_s_setprio(1); _Pragma("unroll") for (int m = 0; m < 4; ++m) _Pragma("unroll") for (int n = 0; n < 2; ++n) _Pragma("unroll") for (int k = 0; k < 2; ++k) \
        acc[ai][bj][m][n] = __builtin_amdgcn_mfma_f32_16x16x32_bf16(Bt[n][k], At[m][k], acc[ai][bj][m][n], 0, 0, 0); __builtin_amdgcn_s_setprio(0); } while (0)
#define PG8_WAIT_V(n) asm volatile("s_waitcnt vmcnt(" #n ")" ::: "memory")
#define PG8_WAIT_L(n) asm volatile("s_waitcnt lgkmcnt(" #n ")" ::: "memory")
#define PG8_BAR __builtin_amdgcn_s_barrier()
#define PG8_SCHED __builtin_amdgcn_sched_barrier(0)
    Unit cur, nxt; int ui = 0;
    if (!S.next(0, cur)) return;
    f32x4 acc[2][2][4][2];
#pragma unroll
    for (int a = 0; a < 2; ++a)
#pragma unroll
        for (int b = 0; b < 2; ++b)
#pragma unroll
            for (int m = 0; m < 4; ++m)
#pragma unroll
                for (int n = 0; n < 2; ++n) acc[a][b][m][n] = (f32x4){0.f, 0.f, 0.f, 0.f};
    bf16x8 At[4][2], B0[2][2], B1[2][2];
    const char* cA = (const char*)g.A + (size_t)cur.pm * tstep; const char* cB = (const char*)g.Bt + (size_t)cur.pn * tstep;
    S.a_ready(cur);
    PG8_STAGE(PG8_SB(0, 0), cB, voffB); PG8_STAGE(PG8_SA(0, 0), cA, voffA); PG8_STAGE(PG8_SB(0, 1), cB + hstep, voffB); PG8_STAGE(PG8_SA(0, 1), cA + hstep, voffA);
    if (wr == 1) PG8_BAR;
    PG8_WAIT_V(4); PG8_BAR;
    PG8_STAGE(PG8_SB(1, 0), cB + kstep, voffB); PG8_STAGE(PG8_SA(1, 0), cA + kstep, voffA); PG8_STAGE(PG8_SB(1, 1), cB + hstep + kstep, voffB);
    PG8_WAIT_V(6); PG8_BAR;
    PG8_STAMP();
    for (;;) {
        const bool has_next = S.next(ui + 1, nxt);
        const char* nA = has_next ? (const char*)g.A + (size_t)nxt.pm * tstep : cA; const char* nB = has_next ? (const char*)g.Bt + (size_t)nxt.pn * tstep : cB;
        for (int t = 0; t < nt; t += 2) {
            const bool last = (t == nt - 2);
            const char* a1 = cA + (size_t)(t + 1) * kstep;
            const char* a2 = last ? nA : cA + (size_t)(t + 2) * kstep; const char* b2 = last ? nB : cB + (size_t)(t + 2) * kstep;
            const char* a3 = a2 + kstep; const char* b3 = b2 + kstep;
            if (last && has_next) S.a_ready(nxt);
            PG8_LDB(B0, 0, 0); PG8_SCHED; PG8_LDA(At, 0, 0); PG8_STAGE(PG8_SA(1, 1), a1 + hstep, voffA);
            PG8_WAIT_L(8); PG8_BAR; PG8_WAIT_L(0); PG8_MMA(0, 0, At, B0); PG8_BAR; PG8_SCHED;
            PG8_LDB(B1, 0, 1); PG8_STAGE(PG8_SB(0, 0), b2, voffB);
            PG8_BAR; PG8_WAIT_L(0); PG8_MMA(0, 1, At, B1); PG8_BAR;
            PG8_LDA(At, 0, 1); PG8_STAGE(PG8_SA(0, 0), a2, voffA);
            PG8_BAR; PG8_WAIT_L(0); PG8_MMA(1, 0, At, B0); PG8_BAR; PG8_SCHED;
            PG8_STAGE(PG8_SB(0, 1), b2 + hstep, voffB);
            PG8_WAIT_V(6); PG8_BAR; PG8_MMA(1, 1, At, B1); PG8_BAR;
            PG8_LDB(B0, 1, 0); PG8_SCHED; PG8_LDA(At, 1, 0); PG8_STAGE(PG8_SA(0, 1), a2 + hstep, voffA);
            PG8_WAIT_L(8); PG8_BAR; PG8_WAIT_L(0); PG8_MMA(0, 0, At, B0); PG8_BAR; PG8_SCHED;
            PG8_LDB(B1, 1, 1); PG8_STAGE(PG8_SB(1, 0), b3, voffB);
            PG8_BAR; PG8_WAIT_L(0); PG8_MMA(0, 1, At, B1); PG8_BAR;
            PG8_LDA(At, 1, 1); PG8_STAGE(PG8_SA(1, 0), a3, voffA);
            PG8_BAR; PG8_WAIT_L(0); PG8_MMA(1, 0, At, B0); PG8_BAR; PG8_SCHED;
            PG8_STAGE(PG8_SB(1, 1), b3 + hstep, voffB);
            PG8_WAIT_V(6); PG8_BAR; PG8_MMA(1, 1, At, B1); PG8_BAR;
        }
        PG8_STAMP();
        if constexpr (!Epi::AFTER_DRAIN) { E(acc, cur, wr, wc, fr, fq); S.done(cur); }
        PG8_STAMP();
        if (!has_next) break;
#pragma unroll
        for (int a = 0; a < 2; ++a)
#pragma unroll
            for (int b = 0; b < 2; ++b)
#pragma unroll
                for (int m = 0; m < 4; ++m)
#pragma unroll
                    for (int n = 0; n < 2; ++n) acc[a][b][m][n] = (f32x4){0.f, 0.f, 0.f, 0.f};
        cur = nxt; cA = nA; cB = nB; ++ui;
    }
    PG8_WAIT_V(0);
    if (wr == 0) PG8_BAR;
    PG8_BAR;
    if constexpr (Epi::AFTER_DRAIN) { E.fused(acc, cur, wr, wc, fr, fq, lds, wid, lane); S.done(cur); }
    PG8_STAMP();
    if (STAMP && wid == 0) { stamps[lane] = lane < nts ? (((unsigned long long)(unsigned)ts_hi << 32) | (unsigned)ts_lo) : 0ull;
        if (lane == 62) stamps[62] = rt_entry; if (lane == 63) stamps[63] = (unsigned long long)wall_clock64(); }
#undef PG8_STAMP
#undef PG8_SA
#undef PG8_SB
#undef PG8_STAGE
#undef PG8_LDA
#undef PG8_LDB
#undef PG8_MMA
#undef PG8_WAIT_V
#undef PG8_WAIT_L
#undef PG8_BAR
#undef PG8_SCHED
}
}

using namespace pg8;
#define LAS __attribute__((address_space(3)))
typedef float f32x2v __attribute__((ext_vector_type(2)));

constexpr int NTOK = 32768, SEQ = 8192, DM = 1024, DCONV = 512, DATT = 512, NH = 8, DFF = 2816, DIN = 2560, CW = 31;
constexpr float EPS = 1e-6f;
constexpr int LDS_BYTES = 147456;
constexpr int RPB_OFF = 131072;
constexpr int NTHREADS = 512;

constexpr size_t WS_WIN  = 0;
constexpr size_t WS_WOUT = WS_WIN  + (size_t)DIN * DM * 2;
constexpr size_t WS_WGU  = WS_WOUT + (size_t)DM * DM * 2;
constexpr size_t WS_WD   = WS_WGU  + (size_t)2 * DFF * DM * 2;
constexpr size_t WS_H1   = WS_WD   + (size_t)DM * DFF * 2;
constexpr size_t WS_U    = WS_H1   + (size_t)NTOK * DM * 2;
constexpr size_t WS_Q    = WS_U    + (size_t)NTOK * DCONV * 2;
constexpr size_t WS_K    = WS_Q    + (size_t)NTOK * DATT * 2;
constexpr size_t WS_VT   = WS_K    + (size_t)NTOK * DATT * 2;
constexpr size_t WS_MIX  = WS_VT   + (size_t)NTOK * DATT * 2;
constexpr size_t WS_HID  = WS_MIX  + (size_t)NTOK * DM * 2;
constexpr size_t WS_SSP  = WS_HID  + (size_t)NTOK * DFF * 2;
constexpr size_t WS_END  = WS_SSP  + (size_t)NTOK * 16 * 4;

struct Params {
    const float* x; const float* norm1_g; const float* w_in; const float* q_norm_g; const float* k_norm_g; const float* rpb;
    const float* dw_kernel; const float* dw_bias; const float* conv_ln_g; const float* conv_ln_b; const float* w_out; const float* norm2_g;
    const float* w_gate; const float* w_up; const float* w_down;
    float* out; unsigned char* ws; int ph_lo, ph_hi;
};

__device__ __forceinline__ float bf_lo(unsigned u) { return __uint_as_float(u << 16); }
__device__ __forceinline__ float bf_hi(unsigned u) { return __uint_as_float(u & 0xffff0000u); }
__device__ __forceinline__ float sigmoidf_fast(float v) { return __builtin_amdgcn_rcpf(1.0f + __expf(-v)); }

struct EpiIn {
    static constexpr bool PERM = true, AFTER_DRAIN = false;
    bf16_t* U; bf16_t* Q; bf16_t* Kb; const float* qg; const float* kg;
    __device__ __forceinline__ void operator()(const f32x4 (&acc)[2][2][4][2], const Unit& u, int wr, int wc, int fr, int fq) const {
        const int row0 = u.pm * BM + wr * 64 + fr;
        if (u.pn < 4) {
            const int col0 = u.pn * 128 + wc * 32 + 8 * fq;
#pragma unroll
            for (int ai = 0; ai < 2; ++ai)
#pragma unroll
                for (int m = 0; m < 4; ++m) {
                    float v[8];
#pragma unroll
                    for (int n = 0; n < 2; ++n)
#pragma unroll
                        for (int j = 0; j < 4; ++j) v[n * 4 + j] = acc[ai][0][m][n][j] * sigmoidf_fast(acc[ai][1][m][n][j]);
                    u32x4 w; w.x = cvt_pk_bf16(v[0], v[1]); w.y = cvt_pk_bf16(v[2], v[3]); w.z = cvt_pk_bf16(v[4], v[5]); w.w = cvt_pk_bf16(v[6], v[7]);
                    *(u32x4*)(U + (size_t)(row0 + ai * HALF + m * 16) * DCONV + col0) = w;
                }
        } else {
            const bool isq = u.pn < 6;
            bf16_t* O = isq ? Q : Kb; const float* gw = isq ? qg : kg; const float sc = isq ? 0.125f : 1.0f;
            const int hcol = ((u.pn - 4) & 1) * 256 + wc * 64;
            f32x4 gv[2][2];
#pragma unroll
            for (int bj = 0; bj < 2; ++bj)
#pragma unroll
                for (int n = 0; n < 2; ++n) gv[bj][n] = *(const f32x4*)(gw + 32 * bj + 8 * fq + 4 * n) * sc;
#pragma unroll
            for (int ai = 0; ai < 2; ++ai)
#pragma unroll
                for (int m = 0; m < 4; ++m) {
                    float ss = 0.f;
#pragma unroll
                    for (int bj = 0; bj < 2; ++bj)
#pragma unroll
                        for (int n = 0; n < 2; ++n) { const f32x4 a = acc[ai][bj][m][n]; ss += (a[0] * a[0] + a[1] * a[1]) + (a[2] * a[2] + a[3] * a[3]); }
                    ss += __shfl_xor(ss, 16); ss += __shfl_xor(ss, 32);
                    const float rstd = rsqrtf(ss * (1.0f / 64.0f) + EPS);
                    bf16_t* rowp = O + (size_t)(row0 + ai * HALF + m * 16) * DATT + hcol + 8 * fq;
#pragma unroll
                    for (int bj = 0; bj < 2; ++bj) {
                        const f32x4 v0 = acc[ai][bj][m][0] * rstd * gv[bj][0], v1 = acc[ai][bj][m][1] * rstd * gv[bj][1];
                        u32x4 w; w.x = cvt_pk_bf16(v0[0], v0[1]); w.y = cvt_pk_bf16(v0[2], v0[3]); w.z = cvt_pk_bf16(v1[0], v1[1]); w.w = cvt_pk_bf16(v1[2], v1[3]);
                        *(u32x4*)(rowp + 32 * bj) = w;
                    }
                }
        }
    }
};
struct EpiPlainBf16 {
    static constexpr bool PERM = true, AFTER_DRAIN = false;
    bf16_t* O; int ldc;
    __device__ __forceinline__ void operator()(const f32x4 (&acc)[2][2][4][2], const Unit& u, int wr, int wc, int fr, int fq) const {
        const int row0 = u.pm * BM + wr * 64 + fr, col0 = u.pn * BM + wc * 32 + 8 * fq;
#pragma unroll
        for (int ai = 0; ai < 2; ++ai)
#pragma unroll
            for (int m = 0; m < 4; ++m) {
                bf16_t* rowp = O + (size_t)(row0 + ai * HALF + m * 16) * ldc + col0;
#pragma unroll
                for (int bj = 0; bj < 2; ++bj) {
                    const f32x4 v0 = acc[ai][bj][m][0], v1 = acc[ai][bj][m][1];
                    u32x4 w; w.x = cvt_pk_bf16(v0[0], v0[1]); w.y = cvt_pk_bf16(v0[2], v0[3]); w.z = cvt_pk_bf16(v1[0], v1[1]); w.w = cvt_pk_bf16(v1[2], v1[3]);
                    *(u32x4*)(rowp + bj * HALF) = w;
                }
            }
    }
};
struct EpiOut {
    static constexpr bool PERM = false, AFTER_DRAIN = false;
    const float* X; float* X1; bf16_t* X1B; float* SSP;
    __device__ __forceinline__ void operator()(const f32x4 (&acc)[2][2][4][2], const Unit& u, int wr, int wc, int fr, int fq) const {
        const int row0 = u.pm * BM + wr * 64 + fr, col0 = u.pn * BM + wc * 32 + 4 * fq;
#pragma unroll
        for (int ai = 0; ai < 2; ++ai)
#pragma unroll
            for (int m = 0; m < 4; ++m) {
                const int row = row0 + ai * HALF + m * 16; const size_t off = (size_t)row * DM + col0; float ss = 0.f;
#pragma unroll
                for (int bj = 0; bj < 2; ++bj)
#pragma unroll
                    for (int n = 0; n < 2; ++n) {
                        const size_t o = off + bj * HALF + n * 16;
                        const f32x4 v = *(const f32x4*)(X + o) + acc[ai][bj][m][n];
                        *(f32x4*)(X1 + o) = v;
                        uint2 w; w.x = cvt_pk_bf16(v[0], v[1]); w.y = cvt_pk_bf16(v[2], v[3]); *(uint2*)(X1B + o) = w;
                        ss += (v[0] * v[0] + v[1] * v[1]) + (v[2] * v[2] + v[3] * v[3]);
                    }
                ss += __shfl_xor(ss, 16); ss += __shfl_xor(ss, 32);
                if (fq == 0) SSP[(size_t)row * 16 + u.pn * 4 + wc] = ss;
            }
    }
};
struct EpiGU {
    static constexpr bool PERM = true, AFTER_DRAIN = false;
    const float* SSP; bf16_t* HID;
    __device__ __forceinline__ void operator()(const f32x4 (&acc)[2][2][4][2], const Unit& u, int wr, int wc, int fr, int fq) const {
        const int row0 = u.pm * BM + wr * 64 + fr, col0 = u.pn * 128 + wc * 32 + 8 * fq;
#pragma unroll
        for (int ai = 0; ai < 2; ++ai)
#pragma unroll
            for (int m = 0; m < 4; ++m) {
                const int row = row0 + ai * HALF + m * 16;
                const f32x4* sp = (const f32x4*)(SSP + (size_t)row * 16);
                const f32x4 s4 = (sp[0] + sp[1]) + (sp[2] + sp[3]);
                const float rstd = rsqrtf(((s4[0] + s4[1]) + (s4[2] + s4[3])) * (1.0f / 1024.0f) + EPS);
                float v[8];
#pragma unroll
                for (int n = 0; n < 2; ++n)
#pragma unroll
                    for (int j = 0; j < 4; ++j) { const float g = acc[ai][0][m][n][j] * rstd, up = acc[ai][1][m][n][j] * rstd; v[n * 4 + j] = g * sigmoidf_fast(g) * up; }
                u32x4 w; w.x = cvt_pk_bf16(v[0], v[1]); w.y = cvt_pk_bf16(v[2], v[3]); w.z = cvt_pk_bf16(v[4], v[5]); w.w = cvt_pk_bf16(v[6], v[7]);
                *(u32x4*)(HID + (size_t)row * DFF + col0) = w;
            }
    }
};
struct EpiDown {
    static constexpr bool PERM = false, AFTER_DRAIN = false;
    float* OUT;
    __device__ __forceinline__ void operator()(const f32x4 (&acc)[2][2][4][2], const Unit& u, int wr, int wc, int fr, int fq) const {
        const int row0 = u.pm * BM + wr * 64 + fr, col0 = u.pn * BM + wc * 32 + 4 * fq;
#pragma unroll
        for (int ai = 0; ai < 2; ++ai)
#pragma unroll
            for (int m = 0; m < 4; ++m) {
                float* rowp = OUT + (size_t)(row0 + ai * HALF + m * 16) * DM + col0;
#pragma unroll
                for (int bj = 0; bj < 2; ++bj)
#pragma unroll
                    for (int n = 0; n < 2; ++n) { float* p = rowp + bj * HALF + n * 16; *(f32x4*)p = *(const f32x4*)p + acc[ai][bj][m][n]; }
            }
    }
};

__device__ __forceinline__ int win_src_col(int nd) {
    if (nd < 1024) { const int pn = nd >> 8, bj = (nd >> 7) & 1, x = nd & 127; return bj * 512 + pn * 128 + x; }
    if (nd < 2048) { const int e = nd - 1024, pn4 = e >> 8, w = e & 255, bj = w >> 7, wc = (w >> 5) & 3, x = w & 31; return 1024 + pn4 * 256 + wc * 64 + bj * 32 + x; }
    return nd;
}
__device__ __forceinline__ void wt_tile(LAS float* tl, const float* __restrict__ W, int Nsrc, int sc, bf16_t* __restrict__ Wt, int K, int n0, int k0, const float* __restrict__ g, int tid) {
    const int j = tid & 63, kk = tid >> 6;
#pragma unroll
    for (int ps = 0; ps < 8; ++ps) { const int k = k0 + kk + 8 * ps; float v = W[(size_t)k * Nsrc + sc]; if (g) v *= g[k]; tl[(kk + 8 * ps) * 65 + j] = v; }
    __syncthreads();
    const int r = tid >> 3, c8 = tid & 7; float v[8];
#pragma unroll
    for (int q = 0; q < 8; ++q) v[q] = tl[(c8 * 8 + q) * 65 + r];
    u32x4 w; w.x = cvt_pk_bf16(v[0], v[1]); w.y = cvt_pk_bf16(v[2], v[3]); w.z = cvt_pk_bf16(v[4], v[5]); w.w = cvt_pk_bf16(v[6], v[7]);
    *(u32x4*)(Wt + (size_t)(n0 + r) * K + k0 + c8 * 8) = w;
    __syncthreads();
}
__device__ __forceinline__ void phase0(const Params& p, LAS unsigned char* lds, int tid, int wid, int lane) {
    LAS float* tl = (LAS float*)lds;
    bf16_t* Win_t = (bf16_t*)(p.ws + WS_WIN); bf16_t* Wout_t = (bf16_t*)(p.ws + WS_WOUT); bf16_t* Wgu_t = (bf16_t*)(p.ws + WS_WGU); bf16_t* Wd_t = (bf16_t*)(p.ws + WS_WD);
    constexpr int T_IN = 40 * 16, T_OUT = 16 * 16, T_GU = 88 * 16, T_D = 16 * 44, T_ALL = T_IN + T_OUT + T_GU + T_D;
    const int j = tid & 63;
    for (int t = blockIdx.x; t < T_ALL; t += gridDim.x) {
        if (t < T_IN) { const int nt = t >> 4, kt = t & 15; wt_tile(tl, p.w_in, DIN, win_src_col(nt * 64 + j), Win_t, DM, nt * 64, kt * 64, nullptr, tid); }
        else if (t < T_IN + T_OUT) { const int e = t - T_IN, nt = e >> 4, kt = e & 15; wt_tile(tl, p.w_out, DM, nt * 64 + j, Wout_t, DM, nt * 64, kt * 64, nullptr, tid); }
        else if (t < T_IN + T_OUT + T_GU) { const int e = t - T_IN - T_OUT, nt = e >> 4, kt = e & 15; const int nd = nt * 64 + j, pn = nd >> 8, bj = (nd >> 7) & 1, x = nd & 127;
            wt_tile(tl, bj ? p.w_up : p.w_gate, DFF, pn * 128 + x, Wgu_t, DM, nt * 64, kt * 64, p.norm2_g, tid); }
        else { const int e = t - T_IN - T_OUT - T_GU, nt = e / 44, kt = e % 44; wt_tile(tl, p.w_down, DM, nt * 64 + j, Wd_t, DFF, nt * 64, kt * 64, nullptr, tid); }
    }
    bf16_t* H1 = (bf16_t*)(p.ws + WS_H1);
    const f32x4 g0 = *(const f32x4*)(p.norm1_g + lane * 8), g1 = *(const f32x4*)(p.norm1_g + lane * 8 + 4), g2 = *(const f32x4*)(p.norm1_g + 512 + lane * 8), g3 = *(const f32x4*)(p.norm1_g + 512 + lane * 8 + 4);
    for (int row = blockIdx.x * 8 + wid; row < NTOK; row += gridDim.x * 8) {
        const float* xr = p.x + (size_t)row * DM + lane * 8;
        const f32x4 a0 = *(const f32x4*)xr, a1 = *(const f32x4*)(xr + 4), a2 = *(const f32x4*)(xr + 512), a3 = *(const f32x4*)(xr + 516);
        float ss = 0.f;
#pragma unroll
        for (int q = 0; q < 4; ++q) ss += a0[q] * a0[q] + a1[q] * a1[q] + a2[q] * a2[q] + a3[q] * a3[q];
#pragma unroll
        for (int o = 1; o < 64; o <<= 1) ss += __shfl_xor(ss, o);
        const float rstd = rsqrtf(ss * (1.0f / 1024.0f) + EPS);
        const f32x4 b0 = a0 * rstd * g0, b1 = a1 * rstd * g1, b2 = a2 * rstd * g2, b3 = a3 * rstd * g3;
        u32x4 w0, w1; w0.x = cvt_pk_bf16(b0[0], b0[1]); w0.y = cvt_pk_bf16(b0[2], b0[3]); w0.z = cvt_pk_bf16(b1[0], b1[1]); w0.w = cvt_pk_bf16(b1[2], b1[3]);
        w1.x = cvt_pk_bf16(b2[0], b2[1]); w1.y = cvt_pk_bf16(b2[2], b2[3]); w1.z = cvt_pk_bf16(b3[0], b3[1]); w1.w = cvt_pk_bf16(b3[2], b3[3]);
        bf16_t* hr = H1 + (size_t)row * DM + lane * 8;
        *(u32x4*)hr = w0; *(u32x4*)(hr + 512) = w1;
    }
}

constexpr int CT = 32;
constexpr int UB_ROWS = CT + CW - 1;
constexpr int YB_OFF = 63488;
__device__ __forceinline__ void conv_phase(const Params& p, LAS unsigned char* lds, int tid, int wid, int lane) {
    const bf16_t* U = (const bf16_t*)(p.ws + WS_U); bf16_t* MIX = (bf16_t*)(p.ws + WS_MIX);
    const int cp = tid & 255, th = tid >> 8;
    float w0[CW], w1[CW];
#pragma unroll
    for (int j = 0; j < CW; ++j) { const float2 ww = *(const float2*)(p.dw_kernel + j * DCONV + 2 * cp); w0[j] = ww.x; w1[j] = ww.y; }
    const float2 cb = *(const float2*)(p.dw_bias + 2 * cp);
    const f32x4 lg0 = *(const f32x4*)(p.conv_ln_g + lane * 8), lg1 = *(const f32x4*)(p.conv_ln_g + lane * 8 + 4);
    const f32x4 lb0 = *(const f32x4*)(p.conv_ln_b + lane * 8), lb1 = *(const f32x4*)(p.conv_ln_b + lane * 8 + 4);
    LAS unsigned char* ub = lds; LAS float* yb = (LAS float*)(lds + YB_OFF);
    for (int tile = blockIdx.x; tile < NTOK / CT; tile += gridDim.x) {
        const int b = tile >> 8, t0 = (tile & 255) * CT;
        for (int idx = tid; idx < UB_ROWS * 64; idx += NTHREADS) {
            const int rr = idx >> 6, cc = idx & 63, t = t0 - 15 + rr; u32x4 v = (u32x4){0u, 0u, 0u, 0u};
            if (t >= 0 && t < SEQ) v = *(const u32x4*)(U + (size_t)(b * SEQ + t) * DCONV + cc * 8);
            *(LAS u32x4*)(ub + rr * 1024 + cc * 16) = v;
        }
        __syncthreads();
#pragma unroll 1
        for (int sub = 0; sub < 2; ++sub) {
            const int base = th * 16 + sub * 8;
            float a0[8], a1[8];
#pragma unroll
            for (int t = 0; t < 8; ++t) { a0[t] = cb.x; a1[t] = cb.y; }
#pragma unroll
            for (int i = 0; i < 8 + CW - 1; ++i) {
                const unsigned uu = *(const LAS unsigned*)(ub + (base + i) * 1024 + cp * 4); const float u0 = bf_lo(uu), u1 = bf_hi(uu);
#pragma unroll
                for (int t = 0; t < 8; ++t) { const int j = i - t; if (j >= 0 && j < CW) { a0[t] += u0 * w0[j]; a1[t] += u1 * w1[j]; } }
            }
#pragma unroll
            for (int t = 0; t < 8; ++t) *(LAS f32x2v*)(yb + (base + t) * DCONV + 2 * cp) = (f32x2v){a0[t], a1[t]};
        }
        __syncthreads();
#pragma unroll
        for (int q = 0; q < 4; ++q) {
            const int tok = wid * 4 + q;
            const f32x4 y0 = *(const LAS f32x4*)(yb + tok * DCONV + lane * 8), y1 = *(const LAS f32x4*)(yb + tok * DCONV + lane * 8 + 4);
            float s = (y0[0] + y0[1]) + (y0[2] + y0[3]) + (y1[0] + y1[1]) + (y1[2] + y1[3]);
#pragma unroll
            for (int o = 1; o < 64; o <<= 1) s += __shfl_xor(s, o);
            const float mu = s * (1.0f / 512.0f);
            const f32x4 d0 = y0 - mu, d1 = y1 - mu;
            float qv = (d0[0] * d0[0] + d0[1] * d0[1]) + (d0[2] * d0[2] + d0[3] * d0[3]) + (d1[0] * d1[0] + d1[1] * d1[1]) + (d1[2] * d1[2] + d1[3] * d1[3]);
#pragma unroll
            for (int o = 1; o < 64; o <<= 1) qv += __shfl_xor(qv, o);
            const float rstd = rsqrtf(qv * (1.0f / 512.0f) + EPS);
            f32x4 z0 = d0 * rstd * lg0 + lb0, z1 = d1 * rstd * lg1 + lb1;
#pragma unroll
            for (int e = 0; e < 4; ++e) { z0[e] = z0[e] * sigmoidf_fast(z0[e]); z1[e] = z1[e] * sigmoidf_fast(z1[e]); }
            u32x4 w; w.x = cvt_pk_bf16(z0[0], z0[1]); w.y = cvt_pk_bf16(z0[2], z0[3]); w.z = cvt_pk_bf16(z1[0], z1[1]); w.w = cvt_pk_bf16(z1[2], z1[3]);
            *(u32x4*)(MIX + (size_t)(b * SEQ + t0 + tok) * DM + lane * 8) = w;
        }
        __syncthreads();
    }
}

__device__ __forceinline__ void attn_phase(const Params& p, LAS unsigned char* lds, int tid, int wid, int lane) {
    const bf16_t* Q = (const bf16_t*)(p.ws + WS_Q); const bf16_t* Kb = (const bf16_t*)(p.ws + WS_K); const bf16_t* VT = (const bf16_t*)(p.ws + WS_VT); bf16_t* MIX = (bf16_t*)(p.ws + WS_MIX);
    const LAS float* rp = (const LAS float*)(lds + RPB_OFF);
    const int fr = lane & 15, fq = lane >> 4, h = wid;
    for (int unit = blockIdx.x; unit < 4 * 128; unit += gridDim.x) {
        const int b = unit >> 7, r = unit & 127;
        const int rs = min(max(r - 4, 0), 120);
        const size_t tokq0 = (size_t)b * SEQ + r * 64;
#pragma unroll 1
        for (int qb = 0; qb < 4; ++qb) {
            const int win = (qb == 0) ? 0 : (qb == 1) ? 8 : (qb == 2) ? 24 : 32;
            const bf16_t* qp = Q + (tokq0 + 16 * qb + fr) * DATT + h * 64 + 8 * fq;
            const bf16x8 qf0 = *(const bf16x8*)qp, qf1 = *(const bf16x8*)(qp + 32);
            f32x4 s[8][2];
            const int kcA = win + 8 * (fr >> 2) + (fr & 3);
            const bf16_t* kbase = Kb + ((size_t)b * SEQ + rs * 64 + kcA) * DATT + h * 64 + 8 * fq;
#pragma unroll
            for (int i = 0; i < 8; ++i)
#pragma unroll
                for (int t = 0; t < 2; ++t) {
                    const bf16_t* kp = kbase + (size_t)(i * 64 + 4 * t) * DATT;
                    const bf16x8 ka0 = *(const bf16x8*)kp, ka1 = *(const bf16x8*)(kp + 32);
                    f32x4 z = (f32x4){0.f, 0.f, 0.f, 0.f};
                    z = __builtin_amdgcn_mfma_f32_16x16x32_bf16(ka0, qf0, z, 0, 0, 0);
                    s[i][t] = __builtin_amdgcn_mfma_f32_16x16x32_bf16(ka1, qf1, z, 0, 0, 0);
                }
            const int c = 16 * qb + fr, cs = min(max(c - 8, 0), 48);
            const LAS float* rph = rp + h * (15 * 31) + (rs - r + 7) * 31;
            float mx = -1e30f;
#pragma unroll
            for (int i = 0; i < 8; ++i)
#pragma unroll
                for (int t = 0; t < 2; ++t)
#pragma unroll
                    for (int j = 0; j < 4; ++j) {
                        const int kcol = win + 8 * fq + 4 * t + j; const bool valid = (kcol >= cs) && (kcol < cs + 16);
                        const int ci = min(max(kcol - c + 15, 0), 30);
                        const float v = valid ? s[i][t][j] + rph[i * 31 + ci] : -1e30f;
                        s[i][t][j] = v; mx = fmaxf(mx, v);
                    }
            mx = fmaxf(mx, __shfl_xor(mx, 16)); mx = fmaxf(mx, __shfl_xor(mx, 32));
            float sum = 0.f;
#pragma unroll
            for (int i = 0; i < 8; ++i)
#pragma unroll
                for (int t = 0; t < 2; ++t)
#pragma unroll
                    for (int j = 0; j < 4; ++j) { const float e = __expf(s[i][t][j] - mx); s[i][t][j] = e; sum += e; }
            sum += __shfl_xor(sum, 16); sum += __shfl_xor(sum, 32);
            f32x4 o[4];
#pragma unroll
            for (int dt = 0; dt < 4; ++dt) o[dt] = (f32x4){0.f, 0.f, 0.f, 0.f};
            const bf16_t* vbase = VT + (size_t)(h * 64 + fr) * NTOK + (size_t)b * SEQ + rs * 64 + win + 8 * fq;
#pragma unroll
            for (int i = 0; i < 8; ++i) {
                u32x4 pw; pw.x = cvt_pk_bf16(s[i][0][0], s[i][0][1]); pw.y = cvt_pk_bf16(s[i][0][2], s[i][0][3]); pw.z = cvt_pk_bf16(s[i][1][0], s[i][1][1]); pw.w = cvt_pk_bf16(s[i][1][2], s[i][1][3]);
                const bf16x8 pb = __builtin_bit_cast(bf16x8, pw);
#pragma unroll
                for (int dt = 0; dt < 4; ++dt) {
                    const bf16x8 va = *(const bf16x8*)(vbase + (size_t)(16 * dt) * NTOK + i * 64);
                    o[dt] = __builtin_amdgcn_mfma_f32_16x16x32_bf16(va, pb, o[dt], 0, 0, 0);
                }
            }
            const float inv = 1.0f / sum;
            bf16_t* op = MIX + (tokq0 + 16 * qb + fr) * DM + DCONV + h * 64 + 4 * fq;
#pragma unroll
            for (int dt = 0; dt < 4; ++dt) { uint2 w; w.x = cvt_pk_bf16(o[dt][0] * inv, o[dt][1] * inv); w.y = cvt_pk_bf16(o[dt][2] * inv, o[dt][3] * inv); *(uint2*)(op + 16 * dt) = w; }
        }
    }
}

__global__ void __launch_bounds__(NTHREADS, 2) fwd_megakernel(Params p) {
    extern __shared__ __attribute__((aligned(16))) unsigned char lds_raw[];
    LAS unsigned char* lds = (LAS unsigned char*)lds_raw;
    const int tid = threadIdx.x, wid = __builtin_amdgcn_readfirstlane(tid >> 6), lane = tid & 63;
    const int lo = p.ph_lo, hi = p.ph_hi, G = gridDim.x, c = blockIdx.x;
    unsigned char* ws = p.ws;
#define IN(k) (lo <= (k) && (k) < hi)
#define SEAM(k) do { if (IN(k) && IN((k) + 1)) cg::this_grid().sync(); } while (0)
    if (IN(0)) phase0(p, lds, tid, wid, lane);
    SEAM(0);
    if (IN(1)) {
        { Gemm g{(const bf16_t*)(ws + WS_H1), (const bf16_t*)(ws + WS_WIN), NTOK, 2048, DM}; StaticOrder S; S.init(NTOK, 2048, G, c);
          EpiIn E{(bf16_t*)(ws + WS_U), (bf16_t*)(ws + WS_Q), (bf16_t*)(ws + WS_K), p.q_norm_g, p.k_norm_g};
          gemm_phase<EpiIn, StaticOrder, false>(lds, g, S, E, nullptr); }
        { Gemm g{(const bf16_t*)(ws + WS_WIN) + (size_t)2048 * DM, (const bf16_t*)(ws + WS_H1), DATT, NTOK, DM}; StaticOrder S; S.init(DATT, NTOK, G, c);
          EpiPlainBf16 E{(bf16_t*)(ws + WS_VT), NTOK};
          gemm_phase<EpiPlainBf16, StaticOrder, false>(lds, g, S, E, nullptr); }
    }
    SEAM(1);
    if (IN(2)) {
        for (int i = tid; i < NH * 15 * 31; i += NTHREADS) ((LAS float*)(lds + RPB_OFF))[i] = p.rpb[i];
        __syncthreads();
        conv_phase(p, lds, tid, wid, lane);
        attn_phase(p, lds, tid, wid, lane);
    }
    SEAM(2);
    if (IN(3)) {
        Gemm g{(const bf16_t*)(ws + WS_MIX), (const bf16_t*)(ws + WS_WOUT), NTOK, DM, DM}; StaticOrder S; S.init(NTOK, DM, G, c);
        EpiOut E{p.x, p.out, (bf16_t*)(ws + WS_H1), (float*)(ws + WS_SSP)};
        gemm_phase<EpiOut, StaticOrder, false>(lds, g, S, E, nullptr);
    }
    SEAM(3);
    if (IN(4)) {
        Gemm g{(const bf16_t*)(ws + WS_H1), (const bf16_t*)(ws + WS_WGU), NTOK, 2 * DFF, DM}; StaticOrder S; S.init(NTOK, 2 * DFF, G, c);
        EpiGU E{(const float*)(ws + WS_SSP), (bf16_t*)(ws + WS_HID)};
        gemm_phase<EpiGU, StaticOrder, false>(lds, g, S, E, nullptr);
    }
    SEAM(4);
    if (IN(5)) {
        Gemm g{(const bf16_t*)(ws + WS_HID), (const bf16_t*)(ws + WS_WD), NTOK, DM, DFF}; StaticOrder S; S.init(NTOK, DM, G, c);
        EpiDown E{p.out};
        gemm_phase<EpiDown, StaticOrder, false>(lds, g, S, E, nullptr);
    }
#undef IN
#undef SEAM
}

#ifndef N_LAUNCHES
#define N_LAUNCHES 1
#endif
extern "C" void kernel_launch(void* const* d_in, const int* in_sizes, int n_in, void* d_out, int out_size, void* d_ws, size_t ws_size, hipStream_t stream) {
    static int grid = 0;
    if (grid == 0) {
        if (ws_size < WS_END) { fprintf(stderr, "kernel_launch: workspace too small: %zu < %zu\n", ws_size, (size_t)WS_END); grid = -1; return; }
        int dev = 0, cus = 0, per_cu = 0;
        (void)hipGetDevice(&dev); (void)hipDeviceGetAttribute(&cus, hipDeviceAttributeMultiprocessorCount, dev);
        if (hipFuncSetAttribute((const void*)fwd_megakernel, hipFuncAttributeMaxDynamicSharedMemorySize, LDS_BYTES) != hipSuccess) { fprintf(stderr, "kernel_launch: hipFuncSetAttribute failed\n"); grid = -1; return; }
        if (hipOccupancyMaxActiveBlocksPerMultiprocessor(&per_cu, (const void*)fwd_megakernel, NTHREADS, LDS_BYTES) != hipSuccess || per_cu < 1) { fprintf(stderr, "kernel_launch: occupancy query says %d\n", per_cu); per_cu = 1; }
        (void)hipGetLastError();
        grid = cus * 1;
    }
    if (grid < 0) return;
    Params p{};
    p.x = (const float*)d_in[0]; p.norm1_g = (const float*)d_in[1]; p.w_in = (const float*)d_in[2]; p.q_norm_g = (const float*)d_in[3]; p.k_norm_g = (const float*)d_in[4];
    p.rpb = (const float*)d_in[5]; p.dw_kernel = (const float*)d_in[6]; p.dw_bias = (const float*)d_in[7]; p.conv_ln_g = (const float*)d_in[8]; p.conv_ln_b = (const float*)d_in[9];
    p.w_out = (const float*)d_in[10]; p.norm2_g = (const float*)d_in[11]; p.w_gate = (const float*)d_in[12]; p.w_up = (const float*)d_in[13]; p.w_down = (const float*)d_in[14];
    p.out = (float*)d_out; p.ws = (unsigned char*)d_ws;
#if N_LAUNCHES == 1
    p.ph_lo = 0; p.ph_hi = 6;
    void* args[] = {&p};
    hipError_t e = hipLaunchCooperativeKernel((const void*)fwd_megakernel, dim3(grid), dim3(NTHREADS), args, LDS_BYTES, stream);
    if (e != hipSuccess) fprintf(stderr, "cooperative launch failed: %s (grid %d)\n", hipGetErrorString(e), grid);
#else
    for (int ph = 0; ph < 6; ++ph) { p.ph_lo = ph; p.ph_hi = ph + 1; hipLaunchKernelGGL(fwd_megakernel, dim3(grid), dim3(NTHREADS), LDS_BYTES, stream, p); }
#endif
}
```

```cpp
#include <hip/hip_runtime.h>
#include <hip/hip_cooperative_groups.h>
#include <cstdio>
namespace cg = cooperative_groups;
#define N_LAUNCHES 1
namespace pg8 {
#define PG8_LAS __attribute__((address_space(3)))
typedef unsigned short bf16_t;
typedef short bf16x8 __attribute__((ext_vector_type(8)));
typedef float f32x4 __attribute__((ext_vector_type(4)));
typedef unsigned u32x4 __attribute__((ext_vector_type(4)));
constexpr int BM = 256, BK = 64, HALF = 128, HTB = HALF * BK * 2  , STAGE_BYTES = 8 * HTB, NXCD = 8, WGM = 4;

__host__ __device__ __forceinline__ int lds_byte(int r, int c) { const int st = (r >> 4) * 2 + (c >> 5), rr = r & 15, cc = c & 31, ob = rr * 64 + cc * 2; return st * 1024 + (ob ^ (((ob >> 9) & 1) << 5)); }
__host__ __device__ __forceinline__ void stage_rc(int b, int& R, int& C) { const int st = b / 1024, sb = b % 1024, swz = sb ^ (((sb >> 9) & 1) << 5); R = (st >> 1) * 16 + swz / 64; C = (st & 1) * 32 + (swz % 64) / 2; }
__host__ __device__ __forceinline__ int perm32(int rho) { const int n = rho >> 4, i = rho & 15; return 8 * (i >> 2) + 4 * n + (i & 3); }

struct Unit { int pm, pn, alt, ord; };
struct Gemm { const bf16_t* A; const bf16_t* Bt; int M, N, K; const bf16_t* A2; const bf16_t* Bt2; };

struct StaticOrder {
    int nM, nN, nwg, G, c;
    __host__ __device__ void init(int M, int N, int G_, int c_) { nM = M / BM; nN = N / BM; nwg = nM * nN; G = G_; c = c_; }
    __host__ __device__ bool next(int i, Unit& u) const {
        const long L = (long)i * G + c; if (L >= nwg) return false;
        map((int)L, u); return true;
    }
    __host__ __device__ void map(int wgid, Unit& u) const {
        u.alt = 0; u.ord = 0; { const int q = nwg / NXCD, r = nwg % NXCD, xcd = wgid % NXCD, off = wgid / NXCD; wgid = (xcd < r ? xcd * (q + 1) : r * (q + 1) + (xcd - r) * q) + off; }
        const int nig = WGM * nN, gid = wgid / nig, fm = gid * WGM, gsz = (nM - fm) < WGM ? (nM - fm) : WGM;
        u.pm = fm + ((wgid % nig) % gsz); u.pn = (wgid % nig) / gsz;
    }
    __device__ __forceinline__ void a_ready(const Unit&) const {}
    __device__ __forceinline__ void done(const Unit&) const {}
};
__device__ __forceinline__ unsigned cvt_pk_bf16(float lo, float hi) { unsigned r; asm volatile("v_cvt_pk_bf16_f32 %0, %1, %2" : "=v"(r) : "v"(lo), "v"(hi)); return r; }
template <class Epi, class Sched, bool STAMP = false>
__device__ __forceinline__ void gemm_phase(PG8_LAS unsigned char* lds, const Gemm g, const Sched& S, const Epi& E, unsigned long long* stamps) {
    const int tid = threadIdx.x, wid = __builtin_amdgcn_readfirstlane(tid >> 6), lane = tid & 63, wr = wid >> 2, wc = wid & 3, fr = lane & 15, fq = lane >> 4;
    const int K = g.K, nt = K / BK;
    int ts_lo = 0, ts_hi = 0, nts = 0; const unsigned long long rt_entry = STAMP ? (unsigned long long)wall_clock64() : 0ull;
#define PG8_STAMP() do { if (STAMP && wid == 0 && nts < 64) { const unsigned long long _c = (unsigned long long)clock64(); \
        ts_lo = (lane == nts) ? (int)(unsigned)_c : ts_lo; ts_hi = (lane == nts) ? (int)(unsigned)(_c >> 32) : ts_hi; ++nts; } } while (0)
    PG8_STAMP();
    unsigned voffA[2], voffB[2];
#pragma unroll
    for (int i = 0; i < 2; ++i) { int R, C; stage_rc(tid * 16 + i * 8192, R, C); const int Rb = Epi::PERM ? ((R & ~31) + perm32(R & 31)) : R;
        voffA[i] = (unsigned)(R * K + C) * 2u; voffB[i] = (unsigned)(Rb * K + C) * 2u; }
    const size_t kstep = (size_t)(BK * 2);
    const size_t hstep = (size_t)HALF * K * 2;
    const size_t tstep = 2 * hstep;
    const unsigned ldsw = (unsigned)wid * 1024u;
    const int aoff = lds_byte(wr * 64 + fr, fq * 8), boff = lds_byte(wc * 32 + fr, fq * 8);
#define PG8_SA(b, h) (((b) * 2 + (h)) * HTB)
#define PG8_SB(b, h) ((4 + (b) * 2 + (h)) * HTB)
#define PG8_STAGE(bufoff, gbase, voff) do { _Pragma("unroll") for (int _i = 0; _i < 2; ++_i) \
        __builtin_amdgcn_global_load_lds((const unsigned*)((const char*)(gbase) + (voff)[_i]), (PG8_LAS unsigned*)(lds + (bufoff) + ldsw + _i * 8192), 16, 0, 0); } while (0)
#define PG8_LDA(dst, b, h) do { _Pragma("unroll") for (int m = 0; m < 4; ++m) _Pragma("unroll") for (int k = 0; k < 2; ++k) dst[m][k] = *(const PG8_LAS bf16x8*)(lds + PG8_SA(b, h) + aoff + m * 2048 + k * 1024); } while (0)
#define PG8_LDB(dst, b, h) do { _Pragma("unroll") for (int n = 0; n < 2; ++n) _Pragma("unroll") for (int k = 0; k < 2; ++k) dst[n][k] = *(const PG8_LAS bf16x8*)(lds + PG8_SB(b, h) + boff + n * 2048 + k * 1024); } while (0)
#define PG8_MMA(ai, bj, At, Bt) do { __builtin_amdgcn_s_setprio(1); _Pragma("unroll") for (int m = 0; m < 4; ++m) _Pragma("unroll") for (int n = 0; n < 2; ++n) _Pragma("unroll") for (int k = 0; k < 2; ++k) \
        acc[ai][bj][m][n] = __builtin_amdgcn_mfma_f32_16x16x32_bf16(Bt[n][k], At[m][k], acc[ai][bj][m][n], 0, 0, 0); __builtin_amdgcn_s_setprio(0); } while (0)
#define PG8_WAIT_V(n) asm volatile("s_waitcnt vmcnt(" #n ")" ::: "memory")
#define PG8_WAIT_L(n) asm volatile("s_waitcnt lgkmcnt(" #n ")" ::: "memory")
#define PG8_BAR __builtin_amdgcn_s_barrier()
#define PG8_SCHED __builtin_amdgcn_sched_barrier(0)
    Unit cur, nxt; int ui = 0;
    if (!S.next(0, cur)) return;
    f32x4 acc[2][2][4][2];
#pragma unroll
    for (int a = 0; a < 2; ++a)
#pragma unroll
        for (int b = 0; b < 2; ++b)
#pragma unroll
            for (int m = 0; m < 4; ++m)
#pragma unroll
                for (int n = 0; n < 2; ++n) acc[a][b][m][n] = (f32x4){0.f, 0.f, 0.f, 0.f};
    bf16x8 At[4][2], B0[2][2], B1[2][2];
    const char* cA = (const char*)(cur.alt ? g.A2 : g.A) + (size_t)cur.pm * tstep; const char* cB = (const char*)(cur.alt ? g.Bt2 : g.Bt) + (size_t)cur.pn * tstep;
    S.a_ready(cur);
    PG8_STAGE(PG8_SB(0, 0), cB, voffB); PG8_STAGE(PG8_SA(0, 0), cA, voffA); PG8_STAGE(PG8_SB(0, 1), cB + hstep, voffB); PG8_STAGE(PG8_SA(0, 1), cA + hstep, voffA);
    if (wr == 1) PG8_BAR;
    PG8_WAIT_V(4); PG8_BAR;
    PG8_STAGE(PG8_SB(1, 0), cB + kstep, voffB); PG8_STAGE(PG8_SA(1, 0), cA + kstep, voffA); PG8_STAGE(PG8_SB(1, 1), cB + hstep + kstep, voffB);
    PG8_WAIT_V(6); PG8_BAR;
    PG8_STAMP();
    for (;;) {
        const bool has_next = S.next(ui + 1, nxt);
        const char* nA = has_next ? (const char*)(nxt.alt ? g.A2 : g.A) + (size_t)nxt.pm * tstep : cA; const char* nB = has_next ? (const char*)(nxt.alt ? g.Bt2 : g.Bt) + (size_t)nxt.pn * tstep : cB;
        for (int t = 0; t < nt; t += 2) {
            const bool last = (t == nt - 2);
            const char* a1 = cA + (size_t)(t + 1) * kstep;
            const char* a2 = last ? nA : cA + (size_t)(t + 2) * kstep; const char* b2 = last ? nB : cB + (size_t)(t + 2) * kstep;
            const char* a3 = a2 + kstep; const char* b3 = b2 + kstep;
            if (last && has_next) S.a_ready(nxt);
            PG8_LDB(B0, 0, 0); PG8_SCHED; PG8_LDA(At, 0, 0); PG8_STAGE(PG8_SA(1, 1), a1 + hstep, voffA);
            PG8_WAIT_L(8); PG8_BAR; PG8_WAIT_L(0); PG8_MMA(0, 0, At, B0); PG8_BAR; PG8_SCHED;
            PG8_LDB(B1, 0, 1); PG8_STAGE(PG8_SB(0, 0), b2, voffB);
            PG8_BAR; PG8_WAIT_L(0); PG8_MMA(0, 1, At, B1); PG8_BAR;
            PG8_LDA(At, 0, 1); PG8_STAGE(PG8_SA(0, 0), a2, voffA);
            PG8_BAR; PG8_WAIT_L(0); PG8_MMA(1, 0, At, B0); PG8_BAR; PG8_SCHED;
            PG8_STAGE(PG8_SB(0, 1), b2 + hstep, voffB);
            PG8_WAIT_V(6); PG8_BAR; PG8_MMA(1, 1, At, B1); PG8_BAR;
            PG8_LDB(B0, 1, 0); PG8_SCHED; PG8_LDA(At, 1, 0); PG8_STAGE(PG8_SA(0, 1), a2 + hstep, voffA);
            PG8_WAIT_L(8); PG8_BAR; PG8_WAIT_L(0); PG8_MMA(0, 0, At, B0); PG8_BAR; PG8_SCHED;
            PG8_LDB(B1, 1, 1); PG8_STAGE(PG8_SB(1, 0), b3, voffB);
            PG8_BAR; PG8_WAIT_L(0); PG8_MMA(0, 1, At, B1); PG8_BAR;
            PG8_LDA(At, 1, 1); PG8_STAGE(PG8_SA(1, 0), a3, voffA);
            PG8_BAR; PG8_WAIT_L(0); PG8_MMA(1, 0, At, B0); PG8_BAR; PG8_SCHED;
            PG8_STAGE(PG8_SB(1, 1), b3 + hstep, voffB);
            PG8_WAIT_V(6); PG8_BAR; PG8_MMA(1, 1, At, B1); PG8_BAR;
        }
        PG8_STAMP();
        if constexpr (!Epi::AFTER_DRAIN) { E(acc, cur, wr, wc, fr, fq); S.done(cur); }
        PG8_STAMP();
        if (!has_next) break;
#pragma unroll
        for (int a = 0; a < 2; ++a)
#pragma unroll
            for (int b = 0; b < 2; ++b)
#pragma unroll
                for (int m = 0; m < 4; ++m)
#pragma unroll
                    for (int n = 0; n < 2; ++n) acc[a][b][m][n] = (f32x4){0.f, 0.f, 0.f, 0.f};
        cur = nxt; cA = nA; cB = nB; ++ui;
    }
    PG8_WAIT_V(0);
    if (wr == 0) PG8_BAR;
    PG8_BAR;
    if constexpr (Epi::AFTER_DRAIN) { E.fused(acc, cur, wr, wc, fr, fq, lds, wid, lane); S.done(cur); }
    PG8_STAMP();
    if (STAMP && wid == 0) { stamps[lane] = lane < nts ? (((unsigned long long)(unsigned)ts_hi << 32) | (unsigned)ts_lo) : 0ull;
        if (lane == 62) stamps[62] = rt_entry; if (lane == 63) stamps[63] = (unsigned long long)wall_clock64(); }
#undef PG8_STAMP
#undef PG8_SA
#undef PG8_SB
#undef PG8_STAGE
#undef PG8_LDA
#undef PG8_LDB
#undef PG8_MMA
#undef PG8_WAIT_V
#undef PG8_WAIT_L
#undef PG8_BAR
#undef PG8_SCHED
}
}
#define LAS __attribute__((address_space(3)))
#define XB_TMO      128
#define XB_XCNT(j)  (256  + 64 * (j))
#define XB_XSUB(j)  (1280 + 64 * (j))
#define XB_XGEN(j)  (2304 + 64 * (j))
#define XB_TOP      3328
#define XB_TOPGEN   3392
#define XCD_BAR_WORDS 3456
#define XB_SPIN_CAP (1u << 18)

__device__ __forceinline__ unsigned xb_ld(unsigned* p)              { return __hip_atomic_load(p, __ATOMIC_RELAXED, __HIP_MEMORY_SCOPE_AGENT); }
__device__ __forceinline__ unsigned xb_add(unsigned* p, unsigned v) { return __hip_atomic_fetch_add(p, v, __ATOMIC_RELAXED, __HIP_MEMORY_SCOPE_AGENT); }
__device__ __forceinline__ unsigned xb_xcc_id() { return (unsigned)__builtin_amdgcn_s_getreg((3 << 11) | 20) & 0xFu; }
#define XB_SPIN(cond, bar) do { unsigned _sp = 0; while (cond) { __builtin_amdgcn_s_sleep(1); \
    if ((++_sp & 255u) == 0u) { if (xb_ld(&(bar)[XB_TMO])) break; if (_sp > XB_SPIN_CAP) { atomicAdd(&(bar)[XB_TMO], 1u); break; } } } } while (0)

struct XcdBarrier {
    unsigned* bar; unsigned x;
    volatile LAS unsigned* st;
};

__device__ __forceinline__ XcdBarrier xcd_barrier_post(unsigned* bar, volatile LAS unsigned* st) {
    XcdBarrier b; b.bar = bar; b.x = xb_xcc_id(); b.st = st;
    if (threadIdx.x == 0) (void)xb_add(&bar[XB_XCNT(b.x)], 1u);
    return b;
}
__device__ __forceinline__ void xcd_barrier_complete(unsigned* bar, unsigned x, unsigned& nloc, unsigned& nx) {
    const unsigned G = gridDim.x * gridDim.y * gridDim.z;
    unsigned sum, cnt, mine, sp = 0u;
    for (;;) {
        sum = 0u; cnt = 0u; mine = 0u;
#pragma unroll
        for (unsigned j = 0; j < 16; ++j) { const unsigned c = xb_ld(&bar[XB_XCNT(j)]); sum += c; cnt += (c > 0u) ? 1u : 0u; mine = (j == x) ? c : mine; }
        if (sum == G) break;
        __builtin_amdgcn_s_sleep(1);
        if ((++sp & 255u) == 0u) { if (xb_ld(&bar[XB_TMO])) break; if (sp > XB_SPIN_CAP) { atomicAdd(&bar[XB_TMO], 1u); break; } }
    }
    nloc = mine > 0u ? mine : 1u; nx = cnt > 0u ? cnt : 1u;
}

__device__ __forceinline__ void xcd_barrier(const XcdBarrier& b) {
    asm volatile("s_waitcnt vmcnt(0)" ::: "memory");
    __syncthreads();
    if (threadIdx.x == 0) {
        unsigned* bar = b.bar;
        __builtin_amdgcn_s_waitcnt(0);
        unsigned nloc = b.st[0], nx = b.st[1];
        if (nloc == 0u) { xcd_barrier_complete(bar, b.x, nloc, nx); b.st[0] = nloc; b.st[1] = nx; }
        const unsigned old = xb_add(&bar[XB_XSUB(b.x)], 1u);
        const unsigned gen = old / nloc;
        if (old + 1u == (gen + 1u) * nloc) {
            __builtin_amdgcn_fence(__ATOMIC_RELEASE, "agent");
            asm volatile("s_waitcnt vmcnt(0)" ::: "memory");
            const unsigned og = xb_add(&bar[XB_TOP], 1u);
            const unsigned tg = og / nx;
            if (og + 1u == (tg + 1u) * nx) xb_add(&bar[XB_TOPGEN], 1u);
            else XB_SPIN(xb_ld(&bar[XB_TOPGEN]) == tg, bar);
            __builtin_amdgcn_fence(__ATOMIC_ACQUIRE, "agent");
            xb_add(&bar[XB_XGEN(b.x)], 1u);
            asm volatile("s_waitcnt vmcnt(0)" ::: "memory");
        } else {
            XB_SPIN(xb_ld(&bar[XB_XGEN(b.x)]) == gen, bar);
            __builtin_amdgcn_fence(__ATOMIC_ACQUIRE, "agent");
            asm volatile("s_waitcnt vmcnt(0)" ::: "memory");
        }
    }
    __syncthreads();
}


using namespace pg8;

typedef float f32x2v __attribute__((ext_vector_type(2)));

constexpr int NTOK = 32768, SEQ = 8192, DM = 1024, DCONV = 512, DATT = 512, NH = 8, DFF = 2816, DIN = 2560, CW = 31;
constexpr float EPS = 1e-6f;
constexpr int BARLDS_OFF = 131072 + 8 * 15 * 64 * 4;
constexpr int LDS_BYTES = BARLDS_OFF + 16;
constexpr int RPB_OFF = 131072;
constexpr int NTHREADS = 512;

constexpr size_t WS_WIN  = 0;
constexpr size_t WS_WOUT = WS_WIN  + (size_t)DIN * DM * 2;
constexpr size_t WS_WGU  = WS_WOUT + (size_t)DM * DM * 2;
constexpr size_t WS_WD   = WS_WGU  + (size_t)2 * DFF * DM * 2;
constexpr size_t WS_H1   = WS_WD   + (size_t)DM * DFF * 2;
constexpr size_t WS_U    = WS_H1   + (size_t)NTOK * DM * 2;
constexpr size_t WS_Q    = WS_U    + (size_t)NTOK * DCONV * 2;
constexpr size_t WS_K    = WS_Q    + (size_t)NTOK * DATT * 2;
constexpr size_t WS_VT   = WS_K    + (size_t)NTOK * DATT * 2;
constexpr size_t WS_MIX  = WS_VT   + (size_t)NTOK * DATT * 2;
constexpr size_t WS_HID  = WS_MIX  + (size_t)NTOK * DM * 2;
constexpr size_t WS_SSP  = WS_HID  + (size_t)NTOK * DFF * 2;
constexpr size_t WS_RS1  = WS_SSP  + (size_t)NTOK * 16 * 4;
constexpr size_t WS_BAR  = WS_RS1  + (size_t)NTOK * 4;
constexpr size_t WS_END  = WS_BAR  + 16384 + 256 * 512 * 4 + 16384;

struct Params {
    const float* x; const float* norm1_g; const float* w_in; const float* q_norm_g; const float* k_norm_g; const float* rpb;
    const float* dw_kernel; const float* dw_bias; const float* conv_ln_g; const float* conv_ln_b; const float* w_out; const float* norm2_g;
    const float* w_gate; const float* w_up; const float* w_down;
    float* out; unsigned char* ws; int ph_lo, ph_hi;
};

__device__ __forceinline__ float bf_lo(unsigned u) { return __uint_as_float(u << 16); }
__device__ __forceinline__ float bf_hi(unsigned u) { return __uint_as_float(u & 0xffff0000u); }
__device__ __forceinline__ float sigmoidf_fast(float v) { return __builtin_amdgcn_rcpf(1.0f + __expf(-v)); }

struct EpiIn {
    static constexpr bool PERM = true, AFTER_DRAIN = false;
    bf16_t* U; bf16_t* Q; bf16_t* Kb; const LAS float* gl; const LAS float* rs;
    __device__ __forceinline__ void operator()(const f32x4 (&acc)[2][2][4][2], const Unit& u, int wr, int wc, int fr, int fq) const {
        const int row0 = u.pm * BM + wr * 64 + fr;
        if (u.pn < 4) {
            const int col0 = u.pn * 128 + wc * 32 + 8 * fq;
#pragma unroll
            for (int ai = 0; ai < 2; ++ai)
#pragma unroll
                for (int m = 0; m < 4; ++m) {
                    const float r1 = rs[u.ord * 256 + wr * 64 + fr + ai * HALF + m * 16];
                    float v[8];
#pragma unroll
                    for (int n = 0; n < 2; ++n)
#pragma unroll
                        for (int j = 0; j < 4; ++j) v[n * 4 + j] = (acc[ai][0][m][n][j] * r1) * sigmoidf_fast(acc[ai][1][m][n][j] * r1);
                    u32x4 w; w.x = cvt_pk_bf16(v[0], v[1]); w.y = cvt_pk_bf16(v[2], v[3]); w.z = cvt_pk_bf16(v[4], v[5]); w.w = cvt_pk_bf16(v[6], v[7]);
                    *(u32x4*)(U + (size_t)(row0 + ai * HALF + m * 16) * DCONV + col0) = w;
                }
        } else {
            const bool isq = u.pn < 6;
            bf16_t* O = isq ? Q : Kb; const float sc = isq ? 0.125f : 1.0f;
            const int hcol = ((u.pn - 4) & 1) * 256 + wc * 64;
            f32x4 gv[2][2];
#pragma unroll
            for (int bj = 0; bj < 2; ++bj)
#pragma unroll
                for (int n = 0; n < 2; ++n) gv[bj][n] = *(const LAS f32x4*)(gl + (isq ? 0 : 64) + 32 * bj + 8 * fq + 4 * n) * sc;
#pragma unroll
            for (int ai = 0; ai < 2; ++ai)
#pragma unroll
                for (int m = 0; m < 4; ++m) {
                    float ss = 0.f;
#pragma unroll
                    for (int bj = 0; bj < 2; ++bj)
#pragma unroll
                        for (int n = 0; n < 2; ++n) { const f32x4 a = acc[ai][bj][m][n]; ss += (a[0] * a[0] + a[1] * a[1]) + (a[2] * a[2] + a[3] * a[3]); }
                    ss += __shfl_xor(ss, 16); ss += __shfl_xor(ss, 32);
                    const float r1 = rs[u.ord * 256 + wr * 64 + fr + ai * HALF + m * 16];
                    const float rstd = r1 * rsqrtf(ss * (r1 * r1) * (1.0f / 64.0f) + EPS);
                    const int tok = row0 + ai * HALF + m * 16;
                    bf16_t* rowp = isq ? O + (size_t)tok * DATT + hcol + 8 * fq
                                       : O + ((size_t)(tok >> 6) * 8 + (hcol >> 6)) * 4096 + fq * 512 + ((tok >> 2) & 1) * 256 + ((tok & 63) >> 3) * 32 + (tok & 3) * 8;
                    const int bjstep = isq ? 32 : 2048;
#pragma unroll
                    for (int bj = 0; bj < 2; ++bj) {
                        const f32x4 v0 = acc[ai][bj][m][0] * rstd * gv[bj][0], v1 = acc[ai][bj][m][1] * rstd * gv[bj][1];
                        u32x4 w; w.x = cvt_pk_bf16(v0[0], v0[1]); w.y = cvt_pk_bf16(v0[2], v0[3]); w.z = cvt_pk_bf16(v1[0], v1[1]); w.w = cvt_pk_bf16(v1[2], v1[3]);
                        *(u32x4*)(rowp + bjstep * bj) = w;
                    }
                }
        }
    }
};
struct EpiPlainBf16 {
    static constexpr bool PERM = true, AFTER_DRAIN = false;
    bf16_t* O; int ldc; const LAS float* rs;
    __device__ __forceinline__ void operator()(const f32x4 (&acc)[2][2][4][2], const Unit& u, int wr, int wc, int fr, int fq) const {
        const int row0 = u.pm * BM + wr * 64 + fr, col0 = u.pn * BM + wc * 32 + 8 * fq;
#pragma unroll
        for (int ai = 0; ai < 2; ++ai)
#pragma unroll
            for (int m = 0; m < 4; ++m) {
                const int ch = row0 + ai * HALF + m * 16, h = ch >> 6, d = ch & 63;
#pragma unroll
                for (int bj = 0; bj < 2; ++bj) {
                    const int tok = col0 + bj * HALF;
                    const LAS f32x4* rp = (const LAS f32x4*)(rs + u.ord * 256 + bj * HALF + wc * 32 + 8 * fq);
                    const f32x4 v0 = acc[ai][bj][m][0] * rp[0], v1 = acc[ai][bj][m][1] * rp[1];
                    u32x4 w; w.x = cvt_pk_bf16(v0[0], v0[1]); w.y = cvt_pk_bf16(v0[2], v0[3]); w.z = cvt_pk_bf16(v1[0], v1[1]); w.w = cvt_pk_bf16(v1[2], v1[3]);
                    *(u32x4*)(O + ((size_t)(tok >> 6) * 8 + h) * 4096 + (d >> 4) * 1024 + ((tok & 63) >> 3) * 128 + (d & 15) * 8) = w;
                }
            }
    }
};
struct EpiOut {
    static constexpr bool PERM = true, AFTER_DRAIN = false;
    const bf16_t* XB; bf16_t* X1B; float* SSP;
    __device__ __forceinline__ void operator()(const f32x4 (&acc)[2][2][4][2], const Unit& u, int wr, int wc, int fr, int fq) const {
        const int row0 = u.pm * BM + wr * 64 + fr, col0 = u.pn * BM + wc * 32 + 8 * fq;
        u32x4 xv[2][2];
#pragma unroll
        for (int bj = 0; bj < 2; ++bj) xv[0][bj] = __builtin_nontemporal_load((const u32x4*)(XB + (size_t)row0 * DM + col0 + bj * HALF));
#pragma unroll
        for (int g = 0; g < 8; ++g) {
            const int ai = g >> 2, m = g & 3;
            if (g < 7) { const int rown = row0 + ((g + 1) >> 2) * HALF + ((g + 1) & 3) * 16;
#pragma unroll
                for (int bj = 0; bj < 2; ++bj) xv[(g + 1) & 1][bj] = __builtin_nontemporal_load((const u32x4*)(XB + (size_t)rown * DM + col0 + bj * HALF)); }
            asm volatile("" ::: "memory");
            const int row = row0 + ai * HALF + m * 16; const size_t off = (size_t)row * DM + col0; float ss = 0.f;
#pragma unroll
            for (int bj = 0; bj < 2; ++bj) {
                const u32x4 t = xv[g & 1][bj];
                const f32x4 v0 = (f32x4){bf_lo(t.x), bf_hi(t.x), bf_lo(t.y), bf_hi(t.y)} + acc[ai][bj][m][0], v1 = (f32x4){bf_lo(t.z), bf_hi(t.z), bf_lo(t.w), bf_hi(t.w)} + acc[ai][bj][m][1];
                u32x4 w; w.x = cvt_pk_bf16(v0[0], v0[1]); w.y = cvt_pk_bf16(v0[2], v0[3]); w.z = cvt_pk_bf16(v1[0], v1[1]); w.w = cvt_pk_bf16(v1[2], v1[3]);
                *(u32x4*)(X1B + off + bj * HALF) = w;
                ss += ((v0[0] * v0[0] + v0[1] * v0[1]) + (v0[2] * v0[2] + v0[3] * v0[3])) + ((v1[0] * v1[0] + v1[1] * v1[1]) + (v1[2] * v1[2] + v1[3] * v1[3]));
            }
            ss += __shfl_xor(ss, 16); ss += __shfl_xor(ss, 32);
            if (fq == 0) SSP[(size_t)row * 16 + u.pn * 4 + wc] = ss;
            asm volatile("" ::: "memory");
        }
    }
};
template <int MODE> struct EpiGUT {
    static constexpr bool PERM = true, AFTER_DRAIN = false;
    const float* SSP; bf16_t* HID; const LAS float* tab;
    __device__ __forceinline__ void operator()(const f32x4 (&acc)[2][2][4][2], const Unit& u, int wr, int wc, int fr, int fq) const {
        const int row0 = u.pm * BM + wr * 64 + fr, col0 = u.pn * 128 + wc * 32 + 8 * fq;
        if (MODE == 1) return;
        if (MODE == 2) {
#pragma unroll
            for (int ai = 0; ai < 2; ++ai)
#pragma unroll
                for (int m = 0; m < 4; ++m) { const f32x4 v0 = acc[ai][0][m][0] + acc[ai][1][m][0], v1 = acc[ai][0][m][1] + acc[ai][1][m][1];
                    u32x4 w; w.x = cvt_pk_bf16(v0[0], v0[1]); w.y = cvt_pk_bf16(v0[2], v0[3]); w.z = cvt_pk_bf16(v1[0], v1[1]); w.w = cvt_pk_bf16(v1[2], v1[3]);
                    *(u32x4*)(HID + (size_t)(row0 + ai * HALF + m * 16) * DFF + col0) = w; }
            return;
        }
        float rstdv[8];
        if (tab) {
#pragma unroll
            for (int g = 0; g < 8; ++g) rstdv[g] = tab[u.ord * 256 + wr * 64 + fr + (g >> 2) * HALF + (g & 3) * 16];
        } else {
            f32x4 s4[8];
#pragma unroll
            for (int g = 0; g < 8; ++g) s4[g] = *(const f32x4*)(SSP + (size_t)(row0 + (g >> 2) * HALF + (g & 3) * 16) * 16 + 4 * fq);
#pragma unroll
            for (int g = 0; g < 8; ++g) { float ssum = (s4[g][0] + s4[g][1]) + (s4[g][2] + s4[g][3]); ssum += __shfl_xor(ssum, 16); ssum += __shfl_xor(ssum, 32); rstdv[g] = rsqrtf(ssum * (1.0f / 1024.0f) + EPS); }
        }
        asm volatile("" ::: "memory");
#pragma unroll
        for (int g = 0; g < 8; ++g) {
            const int ai = g >> 2, m = g & 3, row = row0 + ai * HALF + m * 16; const float rstd = rstdv[g];
            const float c1 = -1.44269504f * rstd, ir2 = __builtin_amdgcn_rcpf(rstd * rstd);
            float v[8];
#pragma unroll
            for (int n = 0; n < 2; ++n)
#pragma unroll
                for (int j = 0; j < 4; ++j) { const float G_ = acc[ai][0][m][n][j], U_ = acc[ai][1][m][n][j];
                    const float t = __builtin_amdgcn_exp2f(c1 * G_); v[n * 4 + j] = (G_ * U_) * __builtin_amdgcn_rcpf(__builtin_fmaf(ir2, t, ir2)); }
            u32x4 w; w.x = cvt_pk_bf16(v[0], v[1]); w.y = cvt_pk_bf16(v[2], v[3]); w.z = cvt_pk_bf16(v[4], v[5]); w.w = cvt_pk_bf16(v[6], v[7]);
            __builtin_nontemporal_store(w, (u32x4*)(HID + (size_t)row * DFF + col0));
        }
    }
};
typedef EpiGUT<0> EpiGU;
struct EpiDown {
    static constexpr bool PERM = true, AFTER_DRAIN = false;
    const bf16_t* X1B; float* OUT;
    __device__ __forceinline__ void operator()(const f32x4 (&acc)[2][2][4][2], const Unit& u, int wr, int wc, int fr, int fq) const {
        const int row0 = u.pm * BM + wr * 64 + fr, col0 = u.pn * BM + wc * 32 + 8 * fq;
        u32x4 xb[2][2];
#pragma unroll
        for (int bj = 0; bj < 2; ++bj) xb[0][bj] = __builtin_nontemporal_load((const u32x4*)(X1B + (size_t)row0 * DM + col0 + bj * HALF));
#pragma unroll
        for (int g = 0; g < 8; ++g) {
            const int ai = g >> 2, m = g & 3;
            if (g < 7) { const int rown = row0 + ((g + 1) >> 2) * HALF + ((g + 1) & 3) * 16;
#pragma unroll
                for (int bj = 0; bj < 2; ++bj) xb[(g + 1) & 1][bj] = __builtin_nontemporal_load((const u32x4*)(X1B + (size_t)rown * DM + col0 + bj * HALF)); }
            asm volatile("" ::: "memory");
            const size_t off = (size_t)(row0 + ai * HALF + m * 16) * DM + col0;
#pragma unroll
            for (int bj = 0; bj < 2; ++bj) { const u32x4 t = xb[g & 1][bj];
                __builtin_nontemporal_store((f32x4){bf_lo(t.x), bf_hi(t.x), bf_lo(t.y), bf_hi(t.y)} + acc[ai][bj][m][0], (f32x4*)(OUT + off + bj * HALF));
                __builtin_nontemporal_store((f32x4){bf_lo(t.z), bf_hi(t.z), bf_lo(t.w), bf_hi(t.w)} + acc[ai][bj][m][1], (f32x4*)(OUT + off + bj * HALF + 4)); }
            asm volatile("" ::: "memory");
        }
    }
};

struct EpiSumOnly {
    static constexpr bool PERM = false, AFTER_DRAIN = false;
    float* DUMP;
    __device__ __forceinline__ void operator()(const f32x4 (&acc)[2][2][4][2], const Unit& u, int wr, int wc, int fr, int fq) const {
        f32x4 t = (f32x4){0.f, 0.f, 0.f, 0.f};
#pragma unroll
        for (int ai = 0; ai < 2; ++ai)
#pragma unroll
            for (int bj = 0; bj < 2; ++bj)
#pragma unroll
                for (int m = 0; m < 4; ++m)
#pragma unroll
                    for (int n = 0; n < 2; ++n) t += acc[ai][bj][m][n];
        DUMP[(size_t)blockIdx.x * 512 + threadIdx.x] = (t[0] + t[1]) + (t[2] + t[3]);
    }
};

struct RevOrder : StaticOrder {
    int R;
    __device__ void init_rev(int M, int N, int G_, int c_) { init(M, N, G_, c_); R = (nwg + G_ - 1) / G_; }
    __device__ bool next(int i, Unit& u) const { if (i >= R) return false; return StaticOrder::next(R - 1 - i, u); }
};

struct InOrder {
    StaticOrder s1, s2;
    __device__ void init(int G_, int c_) { s1.init(NTOK, 2048, G_, c_); s2.init(DATT, NTOK, G_, c_); }
    __device__ bool next(int i, Unit& u) const {
        const long L = (long)i * s1.G + s1.c;
        if (L < s1.nwg) { s1.map((int)L, u); u.ord = i; return true; }
        if (L < s1.nwg + s2.nwg) { s2.map((int)(L - s1.nwg), u); u.alt = 1; u.ord = i; return true; }
        return false;
    }
    __device__ __forceinline__ void a_ready(const Unit&) const {}
    __device__ __forceinline__ void done(const Unit&) const {}
};
struct EpiInAll {
    static constexpr bool PERM = true, AFTER_DRAIN = false;
    EpiIn e1; EpiPlainBf16 e2;
    __device__ __forceinline__ void operator()(const f32x4 (&acc)[2][2][4][2], const Unit& u, int wr, int wc, int fr, int fq) const {
        if (u.alt) e2(acc, u, wr, wc, fr, fq); else e1(acc, u, wr, wc, fr, fq);
    }
};

struct OrdOrder : StaticOrder {
    __device__ bool next(int i, Unit& u) const { const bool ok = StaticOrder::next(i, u); u.ord = i; return ok; }
};
constexpr int RSTAB_OFF = RPB_OFF;
constexpr int RSTAB_MAX_ROUNDS = (8 * 15 * 64 * 4) / 1024;
constexpr int QKG_OFF = RPB_OFF;
constexpr int RS1TAB_OFF = RPB_OFF + 1024;
__device__ __forceinline__ int win_src_col(int nd) {
    if (nd < 1024) { const int pn = nd >> 8, bj = (nd >> 7) & 1, x = nd & 127; return bj * 512 + pn * 128 + x; }
    if (nd < 2048) { const int e = nd - 1024, pn4 = e >> 8, w = e & 255, bj = w >> 7, wc = (w >> 5) & 3, x = w & 31; return 1024 + pn4 * 256 + wc * 64 + bj * 32 + x; }
    return nd;
}
__device__ __forceinline__ void wt_item(const float* __restrict__ W, int Nsrc, int sc, bf16_t* __restrict__ Wt, int K, int n, int k0, const float* __restrict__ g) {
    float v[32];
    const float* wp = W + (size_t)k0 * Nsrc + sc;
#pragma unroll
    for (int q = 0; q < 32; ++q) v[q] = wp[(size_t)q * Nsrc];
    if (g) {
#pragma unroll
        for (int q = 0; q < 32; q += 4) { const f32x4 gv = *(const f32x4*)(g + k0 + q); v[q] *= gv[0]; v[q + 1] *= gv[1]; v[q + 2] *= gv[2]; v[q + 3] *= gv[3]; }
    }
    bf16_t* op = Wt + (size_t)n * K + k0;
#pragma unroll
    for (int q = 0; q < 32; q += 8) { u32x4 w; w.x = cvt_pk_bf16(v[q], v[q + 1]); w.y = cvt_pk_bf16(v[q + 2], v[q + 3]); w.z = cvt_pk_bf16(v[q + 4], v[q + 5]); w.w = cvt_pk_bf16(v[q + 6], v[q + 7]); *(u32x4*)(op + q) = w; }
}
__device__ __forceinline__ void phase0(const Params& p, LAS unsigned char* lds, int tid, int wid, int lane) {
    bf16_t* Win_t = (bf16_t*)(p.ws + WS_WIN); bf16_t* Wout_t = (bf16_t*)(p.ws + WS_WOUT); bf16_t* Wgu_t = (bf16_t*)(p.ws + WS_WGU); bf16_t* Wd_t = (bf16_t*)(p.ws + WS_WD);
    constexpr int T_IN = 40 * 32, T_OUT = 16 * 32, T_GU = 88 * 32, T_D = 16 * 88, T_ALL = T_IN + T_OUT + T_GU + T_D;
    const int gw = blockIdx.x * 8 + wid, nw = gridDim.x * 8;
    for (int t = gw; t < T_ALL; t += nw) {
        if (t < T_IN) { const int nt = t >> 5, kt = t & 31, nd = nt * 64 + lane; wt_item(p.w_in, DIN, win_src_col(nd), Win_t, DM, nd, kt * 32, p.norm1_g); }
        else if (t < T_IN + T_OUT) { const int e = t - T_IN, nt = e >> 5, kt = e & 31, nd = nt * 64 + lane; wt_item(p.w_out, DM, nd, Wout_t, DM, nd, kt * 32, nullptr); }
        else if (t < T_IN + T_OUT + T_GU) { const int e = t - T_IN - T_OUT, nt = e >> 5, kt = e & 31; const int nd = nt * 64 + lane, pn = nd >> 8, bj = (nd >> 7) & 1, x = nd & 127;
            wt_item(bj ? p.w_up : p.w_gate, DFF, pn * 128 + x, Wgu_t, DM, nd, kt * 32, p.norm2_g); }
        else { const int e = t - T_IN - T_OUT - T_GU, nt = e / 88, kt = e % 88, nd = nt * 64 + lane; wt_item(p.w_down, DM, nd, Wd_t, DFF, nd, kt * 32, nullptr); }
    }
    bf16_t* XB = (bf16_t*)(p.ws + WS_H1); float* RS1 = (float*)(p.ws + WS_RS1);
    for (int row = gw * 2; row < NTOK; row += nw * 2) {
        f32x4 a[2][4];
#pragma unroll
        for (int rr = 0; rr < 2; ++rr) { const float* xr = p.x + (size_t)(row + rr) * DM + lane * 8; a[rr][0] = __builtin_nontemporal_load((const f32x4*)xr); a[rr][1] = __builtin_nontemporal_load((const f32x4*)(xr + 4)); a[rr][2] = __builtin_nontemporal_load((const f32x4*)(xr + 512)); a[rr][3] = __builtin_nontemporal_load((const f32x4*)(xr + 516)); }
#pragma unroll
        for (int rr = 0; rr < 2; ++rr) {
            float ss = 0.f;
#pragma unroll
            for (int q = 0; q < 4; ++q) ss += a[rr][0][q] * a[rr][0][q] + a[rr][1][q] * a[rr][1][q] + a[rr][2][q] * a[rr][2][q] + a[rr][3][q] * a[rr][3][q];
#pragma unroll
            for (int o = 1; o < 64; o <<= 1) ss += __shfl_xor(ss, o);
            if (lane == 0) RS1[row + rr] = rsqrtf(ss * (1.0f / 1024.0f) + EPS);
            const f32x4 b0 = a[rr][0], b1 = a[rr][1], b2 = a[rr][2], b3 = a[rr][3];
            u32x4 w0, w1; w0.x = cvt_pk_bf16(b0[0], b0[1]); w0.y = cvt_pk_bf16(b0[2], b0[3]); w0.z = cvt_pk_bf16(b1[0], b1[1]); w0.w = cvt_pk_bf16(b1[2], b1[3]);
            w1.x = cvt_pk_bf16(b2[0], b2[1]); w1.y = cvt_pk_bf16(b2[2], b2[3]); w1.z = cvt_pk_bf16(b3[0], b3[1]); w1.w = cvt_pk_bf16(b3[2], b3[3]);
            bf16_t* hr = XB + (size_t)(row + rr) * DM + lane * 8;
            *(u32x4*)hr = w0; *(u32x4*)(hr + 512) = w1;
        }
    }
}

constexpr int CT = 32;
constexpr int UB_ROWS = CT + CW - 1;
constexpr int YB_OFF = 63488;
__device__ __forceinline__ void conv_phase(const Params& p, LAS unsigned char* lds, int tid, int wid, int lane) {
    const bf16_t* U = (const bf16_t*)(p.ws + WS_U); bf16_t* MIX = (bf16_t*)(p.ws + WS_MIX);
    const int cp = tid & 255, th = tid >> 8;
    f32x2v wv[CW];
#pragma unroll
    for (int j = 0; j < CW; ++j) wv[j] = *(const f32x2v*)(p.dw_kernel + j * DCONV + 2 * cp);
    const f32x2v cb = *(const f32x2v*)(p.dw_bias + 2 * cp);
    const f32x4 lg0 = *(const f32x4*)(p.conv_ln_g + lane * 8), lg1 = *(const f32x4*)(p.conv_ln_g + lane * 8 + 4);
    const f32x4 lb0 = *(const f32x4*)(p.conv_ln_b + lane * 8), lb1 = *(const f32x4*)(p.conv_ln_b + lane * 8 + 4);
    LAS unsigned char* ub = lds; LAS float* yb = (LAS float*)(lds + YB_OFF);
    const bool x8 = (gridDim.x & 7) == 0;
    const int G8 = x8 ? (int)(gridDim.x >> 3) : (int)gridDim.x, xcd = x8 ? (int)(blockIdx.x & 7) : 0, slot = x8 ? (int)(blockIdx.x >> 3) : (int)blockIdx.x, per_xcd = x8 ? ((NTOK / CT) >> 3) : (NTOK / CT);
    u32x4 pre[8];
#define CONV_FETCH(tile_) do { const int b_ = (tile_) >> 8, t0_ = ((tile_) & 255) * CT; _Pragma("unroll") for (int q_ = 0; q_ < 8; ++q_) { const int idx_ = tid + q_ * NTHREADS, rr_ = idx_ >> 6, cc_ = idx_ & 63, t_ = t0_ - 15 + rr_; \
        pre[q_] = (u32x4){0u, 0u, 0u, 0u}; if (idx_ < UB_ROWS * 64 && t_ >= 0 && t_ < SEQ) pre[q_] = *(const u32x4*)(U + (size_t)(b_ * SEQ + t_) * DCONV + cc_ * 8); } } while (0)
#define CONV_PUT() do { _Pragma("unroll") for (int q_ = 0; q_ < 8; ++q_) { const int idx_ = tid + q_ * NTHREADS; if (idx_ < UB_ROWS * 64) *(LAS u32x4*)(ub + (idx_ >> 6) * 1024 + (idx_ & 63) * 16) = pre[q_]; } } while (0)
    if (slot < per_xcd) { CONV_FETCH(xcd * per_xcd + slot); CONV_PUT(); }
    for (int it = slot; it < per_xcd; it += G8) {
        const int tile = xcd * per_xcd + it;
        const int b = tile >> 8, t0 = (tile & 255) * CT;
        const bool has_next = (it + G8) < per_xcd;
        if (has_next) CONV_FETCH(tile + G8);
        __syncthreads();
#pragma unroll 1
        for (int sub = 0; sub < 2; ++sub) {
            const int base = th * 16 + sub * 8;
            f32x2v av[8];
#pragma unroll
            for (int t = 0; t < 8; ++t) av[t] = cb;
#pragma unroll
            for (int i = 0; i < 8 + CW - 1; ++i) {
                const unsigned uu = *(const LAS unsigned*)(ub + (base + i) * 1024 + cp * 4); const f32x2v u2 = (f32x2v){bf_lo(uu), bf_hi(uu)};
#pragma unroll
                for (int t = 0; t < 8; ++t) { const int j = i - t; if (j >= 0 && j < CW) av[t] = __builtin_elementwise_fma(u2, wv[j], av[t]); }
            }
#pragma unroll
            for (int t = 0; t < 8; ++t) *(LAS f32x2v*)(yb + (base + t) * DCONV + 2 * cp) = av[t];
        }
        __syncthreads();
#pragma unroll
        for (int q = 0; q < 4; ++q) {
            const int tok = wid * 4 + q;
            const f32x4 y0 = *(const LAS f32x4*)(yb + tok * DCONV + lane * 8), y1 = *(const LAS f32x4*)(yb + tok * DCONV + lane * 8 + 4);
            float s = (y0[0] + y0[1]) + (y0[2] + y0[3]) + (y1[0] + y1[1]) + (y1[2] + y1[3]);
#pragma unroll
            for (int o = 1; o < 64; o <<= 1) s += __shfl_xor(s, o);
            const float mu = s * (1.0f / 512.0f);
            const f32x4 d0 = y0 - mu, d1 = y1 - mu;
            float qv = (d0[0] * d0[0] + d0[1] * d0[1]) + (d0[2] * d0[2] + d0[3] * d0[3]) + (d1[0] * d1[0] + d1[1] * d1[1]) + (d1[2] * d1[2] + d1[3] * d1[3]);
#pragma unroll
            for (int o = 1; o < 64; o <<= 1) qv += __shfl_xor(qv, o);
            const float rstd = rsqrtf(qv * (1.0f / 512.0f) + EPS);
            f32x4 z0 = d0 * rstd * lg0 + lb0, z1 = d1 * rstd * lg1 + lb1;
#pragma unroll
            for (int e = 0; e < 4; ++e) { z0[e] = z0[e] * sigmoidf_fast(z0[e]); z1[e] = z1[e] * sigmoidf_fast(z1[e]); }
            u32x4 w; w.x = cvt_pk_bf16(z0[0], z0[1]); w.y = cvt_pk_bf16(z0[2], z0[3]); w.z = cvt_pk_bf16(z1[0], z1[1]); w.w = cvt_pk_bf16(z1[2], z1[3]);
            *(u32x4*)(MIX + (size_t)(b * SEQ + t0 + tok) * DM + lane * 8) = w;
        }
        if (has_next) CONV_PUT();
        __syncthreads();
    }
#undef CONV_FETCH
#undef CONV_PUT
}

__device__ __forceinline__ void attn_phase(const Params& p, LAS unsigned char* lds, int tid, int wid, int lane) {
    const bf16_t* Q = (const bf16_t*)(p.ws + WS_Q); const bf16_t* Kb = (const bf16_t*)(p.ws + WS_K); const bf16_t* VT = (const bf16_t*)(p.ws + WS_VT); bf16_t* MIX = (bf16_t*)(p.ws + WS_MIX);
    const LAS float* rp = (const LAS float*)(lds + RPB_OFF);
    const int fr = lane & 15, fq = lane >> 4, h = wid;
    const bool x8 = (gridDim.x & 7) == 0;
    const int G8 = x8 ? (int)(gridDim.x >> 3) : (int)gridDim.x, xcd = x8 ? (int)(blockIdx.x & 7) : 0, slot = x8 ? (int)(blockIdx.x >> 3) : (int)blockIdx.x, per_xcd = x8 ? ((4 * 128) >> 3) : (4 * 128);
    for (int it = slot; it < per_xcd; it += G8) {
        const int unit = xcd * per_xcd + it;
        const int b = unit >> 7, r = unit & 127;
        const int rs = min(max(r - 4, 0), 120);
        const size_t tokq0 = (size_t)b * SEQ + r * 64;
#pragma unroll 1
        for (int qb = 0; qb < 4; ++qb) {
            const int win = (qb == 0) ? 0 : (qb == 1) ? 8 : (qb == 2) ? 24 : 32;
            const bf16_t* qp = Q + (tokq0 + 16 * qb + fr) * DATT + h * 64 + 8 * fq;
            const bf16x8 qf0 = *(const bf16x8*)qp, qf1 = *(const bf16x8*)(qp + 32);
            f32x4 s[8][2];
            const int w8 = win >> 3;
            const bf16_t* kbase = Kb + ((size_t)(b * 128 + rs) * 8 + h) * 4096 + fq * 512 + w8 * 32 + fr * 8;
            const bf16_t* vbase = VT + ((size_t)(b * 128 + rs) * 8 + h) * 4096 + (w8 + fq) * 128 + fr * 8;
            {
                bf16x8 kf[8][2][2];
#pragma unroll
                for (int i = 0; i < 8; ++i)
#pragma unroll
                    for (int t = 0; t < 2; ++t) { const bf16_t* kp = kbase + i * 32768 + t * 256; kf[i][t][0] = *(const bf16x8*)kp; kf[i][t][1] = *(const bf16x8*)(kp + 2048); }
                __builtin_amdgcn_sched_barrier(0);
#pragma unroll
                for (int i = 0; i < 8; ++i)
#pragma unroll
                    for (int t = 0; t < 2; ++t) {
                        f32x4 z = (f32x4){0.f, 0.f, 0.f, 0.f};
                        z = __builtin_amdgcn_mfma_f32_16x16x32_bf16(kf[i][t][0], qf0, z, 0, 0, 0);
                        s[i][t] = __builtin_amdgcn_mfma_f32_16x16x32_bf16(kf[i][t][1], qf1, z, 0, 0, 0);
                    }
            }
            bf16x8 vf[4][4];
#pragma unroll
            for (int i = 0; i < 4; ++i)
#pragma unroll
                for (int dt = 0; dt < 4; ++dt) vf[i][dt] = *(const bf16x8*)(vbase + i * 32768 + dt * 1024);
            __builtin_amdgcn_sched_barrier(0);
            const int c = 16 * qb + fr, cs = min(max(c - 8, 0), 48);
            const LAS float* rph = rp + h * (15 * 64) + (rs - r + 7) * 64 + (win + 8 * fq - c + 15 + 16);
            float bv[8][2][4];
#pragma unroll
            for (int i = 0; i < 8; ++i)
#pragma unroll
                for (int t = 0; t < 2; ++t)
#pragma unroll
                    for (int j = 0; j < 4; ++j) bv[i][t][j] = rph[i * 64 + 4 * t + j];
            float mx = -1e30f;
#pragma unroll
            for (int i = 0; i < 8; ++i)
#pragma unroll
                for (int t = 0; t < 2; ++t)
#pragma unroll
                    for (int j = 0; j < 4; ++j) {
                        const int kcol = win + 8 * fq + 4 * t + j; const bool valid = (kcol >= cs) && (kcol < cs + 16);
                        const float v = valid ? s[i][t][j] + bv[i][t][j] : -1e30f;
                        s[i][t][j] = v; mx = fmaxf(mx, v);
                    }
            mx = fmaxf(mx, __shfl_xor(mx, 16)); mx = fmaxf(mx, __shfl_xor(mx, 32));
            float sum = 0.f;
#pragma unroll
            for (int i = 0; i < 8; ++i)
#pragma unroll
                for (int t = 0; t < 2; ++t)
#pragma unroll
                    for (int j = 0; j < 4; ++j) { const float e = __expf(s[i][t][j] - mx); s[i][t][j] = e; sum += e; }
            sum += __shfl_xor(sum, 16); sum += __shfl_xor(sum, 32);
            f32x4 o[4];
#pragma unroll
            for (int dt = 0; dt < 4; ++dt) o[dt] = (f32x4){0.f, 0.f, 0.f, 0.f};
            bf16x8 vg[4][4];
#pragma unroll
            for (int i = 0; i < 4; ++i)
#pragma unroll
                for (int dt = 0; dt < 4; ++dt) vg[i][dt] = *(const bf16x8*)(vbase + (i + 4) * 32768 + dt * 1024);
            __builtin_amdgcn_sched_barrier(0);
#pragma unroll
            for (int i = 0; i < 8; ++i) {
                u32x4 pw; pw.x = cvt_pk_bf16(s[i][0][0], s[i][0][1]); pw.y = cvt_pk_bf16(s[i][0][2], s[i][0][3]); pw.z = cvt_pk_bf16(s[i][1][0], s[i][1][1]); pw.w = cvt_pk_bf16(s[i][1][2], s[i][1][3]);
                const bf16x8 pb = __builtin_bit_cast(bf16x8, pw);
#pragma unroll
                for (int dt = 0; dt < 4; ++dt) o[dt] = __builtin_amdgcn_mfma_f32_16x16x32_bf16(i < 4 ? vf[i & 3][dt] : vg[i & 3][dt], pb, o[dt], 0, 0, 0);
            }
            const float inv = 1.0f / sum;
            bf16_t* op = MIX + (tokq0 + 16 * qb + fr) * DM + DCONV + h * 64 + 4 * fq;
#pragma unroll
            for (int dt = 0; dt < 4; ++dt) { uint2 w; w.x = cvt_pk_bf16(o[dt][0] * inv, o[dt][1] * inv); w.y = cvt_pk_bf16(o[dt][2] * inv, o[dt][3] * inv); *(uint2*)(op + 16 * dt) = w; }
        }
    }
}


__device__ __forceinline__ void stagger_start(int group, int ticks) {
    if (group > 0) { const unsigned long long t0 = __builtin_amdgcn_s_memrealtime(), want = (unsigned long long)(group * ticks);
        while (__builtin_amdgcn_s_memrealtime() - t0 < want) __builtin_amdgcn_s_sleep(16); }
}
#ifndef STAG4
#define STAG4 160
#endif
__global__ void __launch_bounds__(NTHREADS, 2) fwd_megakernel(Params p) {
    extern __shared__ __attribute__((aligned(16))) unsigned char lds_raw[];
    LAS unsigned char* lds = (LAS unsigned char*)lds_raw;
    const int tid = threadIdx.x, wid = __builtin_amdgcn_readfirstlane(tid >> 6), lane = tid & 63;
    const int lo = p.ph_lo, hi = p.ph_hi, G = gridDim.x, c = blockIdx.x;
    unsigned char* ws = p.ws;
#define IN(k) (lo <= (k) && (k) < hi)
#ifndef PROBE_REPEAT
#define PROBE_REPEAT -1
#endif
#define REP(k) for (int rep_ = 0; rep_ < ((PROBE_REPEAT == (k)) ? 2 : 1); ++rep_)
#define SEAM(k) do { if (IN(k) && IN((k) + 1)) xcd_barrier(bar); } while (0)
    if (lo > hi) cg::this_grid().sync();
    XcdBarrier bar; bar.bar = (unsigned*)(ws + WS_BAR); bar.x = 0; bar.st = nullptr;
    if (hi - lo > 1) {
        if (tid < 4) ((LAS unsigned*)(lds + BARLDS_OFF))[tid] = 0u;
        __syncthreads();
        bar = xcd_barrier_post((unsigned*)(ws + WS_BAR), (volatile LAS unsigned*)(lds + BARLDS_OFF));
    }
    if (IN(0)) REP(0) phase0(p, lds, tid, wid, lane);
    SEAM(0);
#if defined(PROBE_SYNCS)
    for (int q_ = 0; q_ < PROBE_SYNCS; ++q_) xcd_barrier(bar);
#endif
    if (IN(1)) REP(1) {
        Gemm g{(const bf16_t*)(ws + WS_H1), (const bf16_t*)(ws + WS_WIN), NTOK, 2048, DM, (const bf16_t*)(ws + WS_WIN) + (size_t)2048 * DM, (const bf16_t*)(ws + WS_H1)};
        InOrder S; S.init(G, c);
        LAS float* gl = (LAS float*)(lds + QKG_OFF); LAS float* rs = (LAS float*)(lds + RS1TAB_OFF);
        if (tid < 128) gl[tid] = tid < 64 ? p.q_norm_g[tid] : p.k_norm_g[tid - 64];
        {
            const int rounds1 = (S.s1.nwg + S.s2.nwg + G - 1) / G;
            for (int e = tid; e < rounds1 * 256 && e < 29 * 256; e += NTHREADS) { Unit uu; if (S.next(e >> 8, uu)) rs[e] = ((const float*)(ws + WS_RS1))[(uu.alt ? uu.pn : uu.pm) * BM + (e & 255)]; }
        }
        __syncthreads();
        EpiInAll E{EpiIn{(bf16_t*)(ws + WS_U), (bf16_t*)(ws + WS_Q), (bf16_t*)(ws + WS_K), gl, rs}, EpiPlainBf16{(bf16_t*)(ws + WS_VT), NTOK, rs}};
#if defined(PROBE_KLOOP) && PROBE_KLOOP == 1
        { EpiSumOnly E2{(float*)(ws + WS_BAR + 16384)}; gemm_phase<EpiSumOnly, InOrder, false>(lds, g, S, E2, nullptr); }
#endif
        gemm_phase<EpiInAll, InOrder, false>(lds, g, S, E, nullptr);
    }
    SEAM(1);
    if (IN(2)) REP(2) {
        for (int i = tid; i < NH * 15 * 64; i += NTHREADS) { const int ci = (i & 63) - 16; ((LAS float*)(lds + RPB_OFF))[i] = (ci >= 0 && ci < 31) ? p.rpb[(i >> 6) * 31 + ci] : 0.f; }
        __syncthreads();
        REP(21) attn_phase(p, lds, tid, wid, lane);
        REP(20) conv_phase(p, lds, tid, wid, lane);
    }
    SEAM(2);
    if (IN(3)) REP(3) {
        Gemm g{(const bf16_t*)(ws + WS_MIX), (const bf16_t*)(ws + WS_WOUT), NTOK, DM, DM}; StaticOrder S; S.init(NTOK, DM, G, c);
        EpiOut E{(const bf16_t*)(ws + WS_H1), (bf16_t*)(ws + WS_H1), (float*)(ws + WS_SSP)};
        gemm_phase<EpiOut, StaticOrder, false>(lds, g, S, E, nullptr);
    }
    SEAM(3);
    if (IN(4)) REP(4) {
        Gemm g{(const bf16_t*)(ws + WS_H1), (const bf16_t*)(ws + WS_WGU), NTOK, 2 * DFF, DM}; OrdOrder S; S.init(NTOK, 2 * DFF, G, c);
        const int rounds = (S.nwg + G - 1) / G;
        LAS float* tab = (LAS float*)(lds + RSTAB_OFF);
        const bool use_tab = rounds <= RSTAB_MAX_ROUNDS;
        if (use_tab) {
            for (int e = tid; e < rounds * 256; e += NTHREADS) {
                Unit uu; const int i = e >> 8;
                if (S.next(i, uu)) { const f32x4* sp = (const f32x4*)((const float*)(ws + WS_SSP) + (size_t)(uu.pm * BM + (e & 255)) * 16);
                    const f32x4 s4 = (sp[0] + sp[1]) + (sp[2] + sp[3]); tab[e] = rsqrtf(((s4[0] + s4[1]) + (s4[2] + s4[3])) * (1.0f / 1024.0f) + EPS); }
            }
            __syncthreads();
        }
        EpiGU E{(const float*)(ws + WS_SSP), (bf16_t*)(ws + WS_HID), use_tab ? tab : nullptr};
#if defined(STAG4G)
        stagger_start((c >> 3) % STAG4G, STAG4T);
#endif
#if defined(PROBE_KLOOP) && PROBE_KLOOP == 4
        { EpiSumOnly E2{(float*)(ws + WS_BAR + 16384)}; gemm_phase<EpiSumOnly, OrdOrder, false>(lds, g, S, E2, nullptr); }
#endif
#if defined(PROBE_GU_MODE)
        { EpiGUT<PROBE_GU_MODE> E2{(const float*)(ws + WS_SSP), (bf16_t*)(ws + WS_HID), nullptr}; gemm_phase<EpiGUT<PROBE_GU_MODE>, OrdOrder, false>(lds, g, S, E2, nullptr); }
#endif
        gemm_phase<EpiGU, OrdOrder, false>(lds, g, S, E, nullptr);
    }
    SEAM(4);
    if (IN(5)) REP(5) {
        Gemm g{(const bf16_t*)(ws + WS_HID), (const bf16_t*)(ws + WS_WD), NTOK, DM, DFF}; RevOrder S; S.init_rev(NTOK, DM, G, c);
        EpiDown E{(const bf16_t*)(ws + WS_H1), p.out};
#if defined(PROBE_KLOOP) && PROBE_KLOOP == 5
        { EpiSumOnly E2{(float*)(ws + WS_BAR + 16384)}; gemm_phase<EpiSumOnly, RevOrder, false>(lds, g, S, E2, nullptr); }
#endif
#if defined(STAG5)
        stagger_start((c >> 3) & 7, STAG5);
#endif
        gemm_phase<EpiDown, RevOrder, false>(lds, g, S, E, nullptr);
    }
#undef IN
#undef SEAM
}

#ifndef N_LAUNCHES
#define N_LAUNCHES 1
#endif
extern "C" void kernel_launch(void* const* d_in, const int* in_sizes, int n_in, void* d_out, int out_size, void* d_ws, size_t ws_size, hipStream_t stream) {
    static int grid = 0;
    if (grid == 0) {
        if (ws_size < WS_END) { fprintf(stderr, "kernel_launch: workspace too small: %zu < %zu\n", ws_size, (size_t)WS_END); grid = -1; return; }
        int dev = 0, cus = 0, per_cu = 0;
        (void)hipGetDevice(&dev); (void)hipDeviceGetAttribute(&cus, hipDeviceAttributeMultiprocessorCount, dev);
        if (hipFuncSetAttribute((const void*)fwd_megakernel, hipFuncAttributeMaxDynamicSharedMemorySize, LDS_BYTES) != hipSuccess) { fprintf(stderr, "kernel_launch: hipFuncSetAttribute failed\n"); grid = -1; return; }
        if (hipOccupancyMaxActiveBlocksPerMultiprocessor(&per_cu, (const void*)fwd_megakernel, NTHREADS, LDS_BYTES) != hipSuccess || per_cu < 1) { fprintf(stderr, "kernel_launch: occupancy query says %d\n", per_cu); per_cu = 1; }
        (void)hipGetLastError();
        grid = cus * 1;
    }
    if (grid < 0) return;
    Params p{};
    p.x = (const float*)d_in[0]; p.norm1_g = (const float*)d_in[1]; p.w_in = (const float*)d_in[2]; p.q_norm_g = (const float*)d_in[3]; p.k_norm_g = (const float*)d_in[4];
    p.rpb = (const float*)d_in[5]; p.dw_kernel = (const float*)d_in[6]; p.dw_bias = (const float*)d_in[7]; p.conv_ln_g = (const float*)d_in[8]; p.conv_ln_b = (const float*)d_in[9];
    p.w_out = (const float*)d_in[10]; p.norm2_g = (const float*)d_in[11]; p.w_gate = (const float*)d_in[12]; p.w_up = (const float*)d_in[13]; p.w_down = (const float*)d_in[14];
    p.out = (float*)d_out; p.ws = (unsigned char*)d_ws;
#if N_LAUNCHES == 1
    p.ph_lo = 0; p.ph_hi = 6;
#if defined(PROBE_MEMSET)
    for (int q_ = 0; q_ < PROBE_MEMSET; ++q_) (void)hipMemsetAsync((char*)d_ws + WS_BAR + 16384 + 256 * 512 * 4, 0, 16384, stream);
#endif
    if (hipMemsetAsync((char*)d_ws + WS_BAR, 0, 16384, stream) != hipSuccess) { fprintf(stderr, "kernel_launch: hipMemsetAsync failed\n"); return; }
    void* args[] = {&p};
    hipError_t e = hipLaunchCooperativeKernel((const void*)fwd_megakernel, dim3(grid), dim3(NTHREADS), args, LDS_BYTES, stream);
    if (e != hipSuccess) fprintf(stderr, "cooperative launch failed: %s (grid %d)\n", hipGetErrorString(e), grid);
#else
    for (int ph = 0; ph < 6; ++ph) { p.ph_lo = ph; p.ph_hi = ph + 1; hipLaunchKernelGGL(fwd_megakernel, dim3(grid), dim3(NTHREADS), LDS_BYTES, stream, p); }
#endif
}
```

```cpp
#include <hip/hip_runtime.h>
#include <hip/hip_cooperative_groups.h>
#include <cstdio>
namespace cg = cooperative_groups;
#define N_LAUNCHES 1
namespace pg8 {
#define PG8_LAS __attribute__((address_space(3)))
typedef unsigned short bf16_t;
typedef short bf16x8 __attribute__((ext_vector_type(8)));
typedef float f32x4 __attribute__((ext_vector_type(4)));
typedef unsigned u32x4 __attribute__((ext_vector_type(4)));
constexpr int BM = 256, BK = 64, HALF = 128, HTB = HALF * BK * 2  , STAGE_BYTES = 8 * HTB, NXCD = 8, WGM = 4;

__host__ __device__ __forceinline__ int lds_byte(int r, int c) { const int st = (r >> 4) * 2 + (c >> 5), rr = r & 15, cc = c & 31, ob = rr * 64 + cc * 2; return st * 1024 + (ob ^ (((ob >> 9) & 1) << 5)); }
__host__ __device__ __forceinline__ void stage_rc(int b, int& R, int& C) { const int st = b / 1024, sb = b % 1024, swz = sb ^ (((sb >> 9) & 1) << 5); R = (st >> 1) * 16 + swz / 64; C = (st & 1) * 32 + (swz % 64) / 2; }
__host__ __device__ __forceinline__ int perm32(int rho) { const int n = rho >> 4, i = rho & 15; return 8 * (i >> 2) + 4 * n + (i & 3); }

struct Unit { int pm, pn, alt, ord; };
struct Gemm { const bf16_t* A; const bf16_t* Bt; int M, N, K; const bf16_t* A2; const bf16_t* Bt2; };

struct StaticOrder {
    int nM, nN, nwg, G, c;
    __host__ __device__ void init(int M, int N, int G_, int c_) { nM = M / BM; nN = N / BM; nwg = nM * nN; G = G_; c = c_; }
    __host__ __device__ bool next(int i, Unit& u) const {
        const long L = (long)i * G + c; if (L >= nwg) return false;
        map((int)L, u); return true;
    }
    __host__ __device__ void map(int wgid, Unit& u) const {
        u.alt = 0; u.ord = 0; { const int q = nwg / NXCD, r = nwg % NXCD, xcd = wgid % NXCD, off = wgid / NXCD; wgid = (xcd < r ? xcd * (q + 1) : r * (q + 1) + (xcd - r) * q) + off; }
        const int nig = WGM * nN, gid = wgid / nig, fm = gid * WGM, gsz = (nM - fm) < WGM ? (nM - fm) : WGM;
        u.pm = fm + ((wgid % nig) % gsz); u.pn = (wgid % nig) / gsz;
    }
    __device__ __forceinline__ void a_ready(const Unit&) const {}
    __device__ __forceinline__ void done(const Unit&) const {}
};
__device__ __forceinline__ unsigned cvt_pk_bf16(float lo, float hi) { unsigned r; asm volatile("v_cvt_pk_bf16_f32 %0, %1, %2" : "=v"(r) : "v"(lo), "v"(hi)); return r; }
template <class Epi, class Sched, bool STAMP = false>
__device__ __forceinline__ void gemm_phase(PG8_LAS unsigned char* lds, const Gemm g, const Sched& S, const Epi& E, unsigned long long* stamps) {
    const int tid = threadIdx.x, wid = __builtin_amdgcn_readfirstlane(tid >> 6), lane = tid & 63, wr = wid >> 2, wc = wid & 3, fr = lane & 15, fq = lane >> 4;
    const int K = g.K, nt = K / BK;
    int ts_lo = 0, ts_hi = 0, nts = 0; const unsigned long long rt_entry = STAMP ? (unsigned long long)wall_clock64() : 0ull;
#define PG8_STAMP() do { if (STAMP && wid == 0 && nts < 64) { const unsigned long long _c = (unsigned long long)clock64(); \
        ts_lo = (lane == nts) ? (int)(unsigned)_c : ts_lo; ts_hi = (lane == nts) ? (int)(unsigned)(_c >> 32) : ts_hi; ++nts; } } while (0)
    PG8_STAMP();
    unsigned voffA[2], voffB[2];
#pragma unroll
    for (int i = 0; i < 2; ++i) { int R, C; stage_rc(tid * 16 + i * 8192, R, C); const int Rb = Epi::PERM ? ((R & ~31) + perm32(R & 31)) : R;
        voffA[i] = (unsigned)(R * K + C) * 2u; voffB[i] = (unsigned)(Rb * K + C) * 2u; }
    const size_t kstep = (size_t)(BK * 2);
    const size_t hstep = (size_t)HALF * K * 2;
    const size_t tstep = 2 * hstep;
    const unsigned ldsw = (unsigned)wid * 1024u;
    const int aoff = lds_byte(wr * 64 + fr, fq * 8), boff = lds_byte(wc * 32 + fr, fq * 8);
#define PG8_SA(b, h) (((b) * 2 + (h)) * HTB)
#define PG8_SB(b, h) ((4 + (b) * 2 + (h)) * HTB)
#define PG8_STAGE(bufoff, gbase, voff) do { _Pragma("unroll") for (int _i = 0; _i < 2; ++_i) \
        __builtin_amdgcn_global_load_lds((const unsigned*)((const char*)(gbase) + (voff)[_i]), (PG8_LAS unsigned*)(lds + (bufoff) + ldsw + _i * 8192), 16, 0, 0); } while (0)
#define PG8_LDA(dst, b, h) do { _Pragma("unroll") for (int m = 0; m < 4; ++m) _Pragma("unroll") for (int k = 0; k < 2; ++k) dst[m][k] = *(const PG8_LAS bf16x8*)(lds + PG8_SA(b, h) + aoff + m * 2048 + k * 1024); } while (0)
#define PG8_LDB(dst, b, h) do { _Pragma("unroll") for (int n = 0; n < 2; ++n) _Pragma("unroll") for (int k = 0; k < 2; ++k) dst[n][k] = *(const PG8_LAS bf16x8*)(lds + PG8_SB(b, h) + boff + n * 2048 + k * 1024); } while (0)
#define PG8_MMA(ai, bj, At, Bt) do { __builtin_amdgcn_s_setprio(1); _Pragma("unroll") for (int m = 0; m < 4; ++m) _Pragma("unroll") for (int n = 0; n < 2; ++n) _Pragma("unroll") for (int k = 0; k < 2; ++k) \
        acc[ai][bj][m][n] = __builtin_amdgcn_mfma_f32_16x16x32_bf16(Bt[n][k], At[m][k], acc[ai][bj][m][n], 0, 0, 0); __builtin_amdgcn_s_setprio(0); } while (0)
#define PG8_WAIT_V(n) asm volatile("s_waitcnt vmcnt(" #n ")" ::: "memory")
#define PG8_WAIT_L(n) asm volatile("s_waitcnt lgkmcnt(" #n ")" ::: "memory")
#define PG8_BAR __builtin_amdgcn_s_barrier()
#define PG8_SCHED __builtin_amdgcn_sched_barrier(0)
    Unit cur, nxt; int ui = 0;
    if (!S.next(0, cur)) return;
    f32x4 acc[2][2][4][2];
#pragma unroll
    for (int a = 0; a < 2; ++a)
#pragma unroll
        for (int b = 0; b < 2; ++b)
#pragma unroll
            for (int m = 0; m < 4; ++m)
#pragma unroll
                for (int n = 0; n < 2; ++n) acc[a][b][m][n] = (f32x4){0.f, 0.f, 0.f, 0.f};
    bf16x8 At[4][2], B0[2][2], B1[2][2];
    const char* cA = (const char*)(cur.alt ? g.A2 : g.A) + (size_t)cur.pm * tstep; const char* cB = (const char*)(cur.alt ? g.Bt2 : g.Bt) + (size_t)cur.pn * tstep;
    S.a_ready(cur);
    PG8_STAGE(PG8_SB(0, 0), cB, voffB); PG8_STAGE(PG8_SA(0, 0), cA, voffA); PG8_STAGE(PG8_SB(0, 1), cB + hstep, voffB); PG8_STAGE(PG8_SA(0, 1), cA + hstep, voffA);
    if (wr == 1) PG8_BAR;
    PG8_WAIT_V(4); PG8_BAR;
    PG8_STAGE(PG8_SB(1, 0), cB + kstep, voffB); PG8_STAGE(PG8_SA(1, 0), cA + kstep, voffA); PG8_STAGE(PG8_SB(1, 1), cB + hstep + kstep, voffB);
    PG8_WAIT_V(6); PG8_BAR;
    PG8_STAMP();
    for (;;) {
        const bool has_next = S.next(ui + 1, nxt);
        const char* nA = has_next ? (const char*)(nxt.alt ? g.A2 : g.A) + (size_t)nxt.pm * tstep : cA; const char* nB = has_next ? (const char*)(nxt.alt ? g.Bt2 : g.Bt) + (size_t)nxt.pn * tstep : cB;
        for (int t = 0; t < nt; t += 2) {
            const bool last = (t == nt - 2);
            const char* a1 = cA + (size_t)(t + 1) * kstep;
            const char* a2 = last ? nA : cA + (size_t)(t + 2) * kstep; const char* b2 = last ? nB : cB + (size_t)(t + 2) * kstep;
            const char* a3 = a2 + kstep; const char* b3 = b2 + kstep;
            if (last && has_next) S.a_ready(nxt);
            PG8_LDB(B0, 0, 0); PG8_SCHED; PG8_LDA(At, 0, 0); PG8_STAGE(PG8_SA(1, 1), a1 + hstep, voffA);
            PG8_WAIT_L(8); PG8_BAR; PG8_WAIT_L(0); PG8_MMA(0, 0, At, B0); PG8_BAR; PG8_SCHED;
            PG8_LDB(B1, 0, 1); PG8_STAGE(PG8_SB(0, 0), b2, voffB);
            PG8_BAR; PG8_WAIT_L(0); PG8_MMA(0, 1, At, B1); PG8_BAR;
            PG8_LDA(At, 0, 1); PG8_STAGE(PG8_SA(0, 0), a2, voffA);
            PG8_BAR; PG8_WAIT_L(0); PG8_MMA(1, 0, At, B0); PG8_BAR; PG8_SCHED;
            PG8_STAGE(PG8_SB(0, 1), b2 + hstep, voffB);
            PG8_WAIT_V(6); PG8_BAR; PG8_MMA(1, 1, At, B1); PG8_BAR;
            PG8_LDB(B0, 1, 0); PG8_SCHED; PG8_LDA(At, 1, 0); PG8_STAGE(PG8_SA(0, 1), a2 + hstep, voffA);
            PG8_WAIT_L(8); PG8_BAR; PG8_WAIT_L(0); PG8_MMA(0, 0, At, B0); PG8_BAR; PG8_SCHED;
            PG8_LDB(B1, 1, 1); PG8_STAGE(PG8_SB(1, 0), b3, voffB);
            PG8_BAR; PG8_WAIT_L(0); PG8_MMA(0, 1, At, B1); PG8_BAR;
            PG8_LDA(At, 1, 1); PG8_STAGE(PG8_SA(1, 0), a3, voffA);
            PG8_BAR; PG8_WAIT_L(0); PG8_MMA(1, 0, At, B0); PG8_BAR; PG8_SCHED;
            PG8_STAGE(PG8_SB(1, 1), b3 + hstep, voffB);
            PG8_WAIT_V(6); PG8_BAR; PG8_MMA(1, 1, At, B1); PG8_BAR;
        }
        PG8_STAMP();
        if constexpr (!Epi::AFTER_DRAIN) { E(acc, cur, wr, wc, fr, fq); S.done(cur); }
        PG8_STAMP();
        if (!has_next) break;
#pragma unroll
        for (int a = 0; a < 2; ++a)
#pragma unroll
            for (int b = 0; b < 2; ++b)
#pragma unroll
                for (int m = 0; m < 4; ++m)
#pragma unroll
                    for (int n = 0; n < 2; ++n) acc[a][b][m][n] = (f32x4){0.f, 0.f, 0.f, 0.f};
        cur = nxt; cA = nA; cB = nB; ++ui;
    }
    PG8_WAIT_V(0);
    if (wr == 0) PG8_BAR;
    PG8_BAR;
    if constexpr (Epi::AFTER_DRAIN) { E.fused(acc, cur, wr, wc, fr, fq, lds, wid, lane); S.done(cur); }
    PG8_STAMP();
    if (STAMP && wid == 0) { stamps[lane] = lane < nts ? (((unsigned long long)(unsigned)ts_hi << 32) | (unsigned)ts_lo) : 0ull;
        if (lane == 62) stamps[62] = rt_entry; if (lane == 63) stamps[63] = (unsigned long long)wall_clock64(); }
#undef PG8_STAMP
#undef PG8_SA
#undef PG8_SB
#undef PG8_STAGE
#undef PG8_LDA
#undef PG8_LDB
#undef PG8_MMA
#undef PG8_WAIT_V
#undef PG8_WAIT_L
#undef PG8_BAR
#undef PG8_SCHED
}
}
#define LAS __attribute__((address_space(3)))
#define XB_TMO      128
#define XB_XCNT(j)  (256  + 64 * (j))
#define XB_XSUB(j)  (1280 + 64 * (j))
#define XB_XGEN(j)  (2304 + 64 * (j))
#define XB_TOP      3328
#define XB_TOPGEN   3392
#define XCD_BAR_WORDS 3456
#define XB_SPIN_CAP (1u << 18)

__device__ __forceinline__ unsigned xb_ld(unsigned* p)              { return __hip_atomic_load(p, __ATOMIC_RELAXED, __HIP_MEMORY_SCOPE_AGENT); }
__device__ __forceinline__ unsigned xb_add(unsigned* p, unsigned v) { return __hip_atomic_fetch_add(p, v, __ATOMIC_RELAXED, __HIP_MEMORY_SCOPE_AGENT); }
__device__ __forceinline__ unsigned xb_xcc_id() { return (unsigned)__builtin_amdgcn_s_getreg((3 << 11) | 20) & 0xFu; }
#define XB_SPIN(cond, bar) do { unsigned _sp = 0; while (cond) { __builtin_amdgcn_s_sleep(1); \
    if ((++_sp & 255u) == 0u) { if (xb_ld(&(bar)[XB_TMO])) break; if (_sp > XB_SPIN_CAP) { atomicAdd(&(bar)[XB_TMO], 1u); break; } } } } while (0)

struct XcdBarrier {
    unsigned* bar; unsigned x;
    volatile LAS unsigned* st;
};

__device__ __forceinline__ XcdBarrier xcd_barrier_post(unsigned* bar, volatile LAS unsigned* st) {
    XcdBarrier b; b.bar = bar; b.x = xb_xcc_id(); b.st = st;
    if (threadIdx.x == 0) (void)xb_add(&bar[XB_XCNT(b.x)], 1u);
    return b;
}
__device__ __forceinline__ void xcd_barrier_complete(unsigned* bar, unsigned x, unsigned& nloc, unsigned& nx) {
    const unsigned G = gridDim.x * gridDim.y * gridDim.z;
    unsigned sum, cnt, mine, sp = 0u;
    for (;;) {
        sum = 0u; cnt = 0u; mine = 0u;
#pragma unroll
        for (unsigned j = 0; j < 16; ++j) { const unsigned c = xb_ld(&bar[XB_XCNT(j)]); sum += c; cnt += (c > 0u) ? 1u : 0u; mine = (j == x) ? c : mine; }
        if (sum == G) break;
        __builtin_amdgcn_s_sleep(1);
        if ((++sp & 255u) == 0u) { if (xb_ld(&bar[XB_TMO])) break; if (sp > XB_SPIN_CAP) { atomicAdd(&bar[XB_TMO], 1u); break; } }
    }
    nloc = mine > 0u ? mine : 1u; nx = cnt > 0u ? cnt : 1u;
}

__device__ __forceinline__ void xcd_barrier(const XcdBarrier& b) {
    asm volatile("s_waitcnt vmcnt(0)" ::: "memory");
    __syncthreads();
    if (threadIdx.x == 0) {
        unsigned* bar = b.bar;
        __builtin_amdgcn_s_waitcnt(0);
        unsigned nloc = b.st[0], nx = b.st[1];
        if (nloc == 0u) { xcd_barrier_complete(bar, b.x, nloc, nx); b.st[0] = nloc; b.st[1] = nx; }
        const unsigned old = xb_add(&bar[XB_XSUB(b.x)], 1u);
        const unsigned gen = old / nloc;
        if (old + 1u == (gen + 1u) * nloc) {
            __builtin_amdgcn_fence(__ATOMIC_RELEASE, "agent");
            asm volatile("s_waitcnt vmcnt(0)" ::: "memory");
            const unsigned og = xb_add(&bar[XB_TOP], 1u);
            const unsigned tg = og / nx;
            if (og + 1u == (tg + 1u) * nx) xb_add(&bar[XB_TOPGEN], 1u);
            else XB_SPIN(xb_ld(&bar[XB_TOPGEN]) == tg, bar);
            __builtin_amdgcn_fence(__ATOMIC_ACQUIRE, "agent");
            xb_add(&bar[XB_XGEN(b.x)], 1u);
            asm volatile("s_waitcnt vmcnt(0)" ::: "memory");
        } else {
            XB_SPIN(xb_ld(&bar[XB_XGEN(b.x)]) == gen, bar);
            __builtin_amdgcn_fence(__ATOMIC_ACQUIRE, "agent");
            asm volatile("s_waitcnt vmcnt(0)" ::: "memory");
        }
    }
    __syncthreads();
}


using namespace pg8;

typedef float f32x2v __attribute__((ext_vector_type(2)));

constexpr int NTOK = 32768, SEQ = 8192, DM = 1024, DCONV = 512, DATT = 512, NH = 8, DFF = 2816, DIN = 2560, CW = 31;
constexpr float EPS = 1e-6f;
constexpr int BARLDS_OFF = 131072 + 8 * 15 * 64 * 4;
constexpr int LDS_BYTES = BARLDS_OFF + 16;
constexpr int RPB_OFF = 131072;
constexpr int NTHREADS = 512;

constexpr size_t WS_WIN  = 0;
constexpr size_t WS_WOUT = WS_WIN  + (size_t)DIN * DM * 2;
constexpr size_t WS_WGU  = WS_WOUT + (size_t)DM * DM * 2;
constexpr size_t WS_WD   = WS_WGU  + (size_t)2 * DFF * DM * 2;
constexpr size_t WS_H1   = WS_WD   + (size_t)DM * DFF * 2;
constexpr size_t WS_U    = WS_H1   + (size_t)NTOK * DM * 2;
constexpr size_t WS_Q    = WS_U    + (size_t)NTOK * DCONV * 2;
constexpr size_t WS_K    = WS_Q    + (size_t)NTOK * DATT * 2;
constexpr size_t WS_VT   = WS_K    + (size_t)NTOK * DATT * 2;
constexpr size_t WS_MIX  = WS_VT   + (size_t)NTOK * DATT * 2;
constexpr size_t WS_HID  = WS_MIX  + (size_t)NTOK * DM * 2;
constexpr size_t WS_SSP  = WS_HID  + (size_t)NTOK * DFF * 2;
constexpr size_t WS_RS1  = WS_SSP  + (size_t)NTOK * 16 * 4;
constexpr size_t WS_BAR  = WS_RS1  + (size_t)NTOK * 4;
constexpr size_t WS_END  = WS_BAR  + 16384 + 256 * 512 * 4 + 16384;

struct Params {
    const float* x; const float* norm1_g; const float* w_in; const float* q_norm_g; const float* k_norm_g; const float* rpb;
    const float* dw_kernel; const float* dw_bias; const float* conv_ln_g; const float* conv_ln_b; const float* w_out; const float* norm2_g;
    const float* w_gate; const float* w_up; const float* w_down;
    float* out; unsigned char* ws; int ph_lo, ph_hi;
};

__device__ __forceinline__ float bf_lo(unsigned u) { return __uint_as_float(u << 16); }
__device__ __forceinline__ float bf_hi(unsigned u) { return __uint_as_float(u & 0xffff0000u); }
__device__ __forceinline__ float sigmoidf_fast(float v) { return __builtin_amdgcn_rcpf(1.0f + __expf(-v)); }

struct EpiIn {
    static constexpr bool PERM = true, AFTER_DRAIN = false;
    bf16_t* U; bf16_t* Q; bf16_t* Kb; const LAS float* gl; const LAS float* rs;
    __device__ __forceinline__ void operator()(const f32x4 (&acc)[2][2][4][2], const Unit& u, int wr, int wc, int fr, int fq) const {
        const int row0 = u.pm * BM + wr * 64 + fr;
        if (u.pn < 4) {
            const int col0 = u.pn * 128 + wc * 32 + 8 * fq;
#pragma unroll
            for (int ai = 0; ai < 2; ++ai)
#pragma unroll
                for (int m = 0; m < 4; ++m) {
                    const float r1 = rs[u.ord * 256 + wr * 64 + fr + ai * HALF + m * 16];
                    float v[8];
#pragma unroll
                    for (int n = 0; n < 2; ++n)
#pragma unroll
                        for (int j = 0; j < 4; ++j) v[n * 4 + j] = (acc[ai][0][m][n][j] * r1) * sigmoidf_fast(acc[ai][1][m][n][j] * r1);
                    u32x4 w; w.x = cvt_pk_bf16(v[0], v[1]); w.y = cvt_pk_bf16(v[2], v[3]); w.z = cvt_pk_bf16(v[4], v[5]); w.w = cvt_pk_bf16(v[6], v[7]);
                    *(u32x4*)(U + (size_t)(row0 + ai * HALF + m * 16) * DCONV + col0) = w;
                }
        } else {
            const bool isq = u.pn < 6;
            bf16_t* O = isq ? Q : Kb; const float sc = isq ? 0.125f : 1.0f;
            const int hcol = ((u.pn - 4) & 1) * 256 + wc * 64;
            f32x4 gv[2][2];
#pragma unroll
            for (int bj = 0; bj < 2; ++bj)
#pragma unroll
                for (int n = 0; n < 2; ++n) gv[bj][n] = *(const LAS f32x4*)(gl + (isq ? 0 : 64) + 32 * bj + 8 * fq + 4 * n) * sc;
#pragma unroll
            for (int ai = 0; ai < 2; ++ai)
#pragma unroll
                for (int m = 0; m < 4; ++m) {
                    float ss = 0.f;
#pragma unroll
                    for (int bj = 0; bj < 2; ++bj)
#pragma unroll
                        for (int n = 0; n < 2; ++n) { const f32x4 a = acc[ai][bj][m][n]; ss += (a[0] * a[0] + a[1] * a[1]) + (a[2] * a[2] + a[3] * a[3]); }
                    ss += __shfl_xor(ss, 16); ss += __shfl_xor(ss, 32);
                    const float r1 = rs[u.ord * 256 + wr * 64 + fr + ai * HALF + m * 16];
                    const float rstd = r1 * rsqrtf(ss * (r1 * r1) * (1.0f / 64.0f) + EPS);
                    const int tok = row0 + ai * HALF + m * 16;
                    bf16_t* rowp = isq ? O + (size_t)tok * DATT + hcol + 8 * fq
                                       : O + ((size_t)(tok >> 6) * 8 + (hcol >> 6)) * 4096 + fq * 512 + ((tok >> 2) & 1) * 256 + ((tok & 63) >> 3) * 32 + (tok & 3) * 8;
                    const int bjstep = isq ? 32 : 2048;
#pragma unroll
                    for (int bj = 0; bj < 2; ++bj) {
                        const f32x4 v0 = acc[ai][bj][m][0] * rstd * gv[bj][0], v1 = acc[ai][bj][m][1] * rstd * gv[bj][1];
                        u32x4 w; w.x = cvt_pk_bf16(v0[0], v0[1]); w.y = cvt_pk_bf16(v0[2], v0[3]); w.z = cvt_pk_bf16(v1[0], v1[1]); w.w = cvt_pk_bf16(v1[2], v1[3]);
                        *(u32x4*)(rowp + bjstep * bj) = w;
                    }
                }
        }
    }
};
struct EpiPlainBf16 {
    static constexpr bool PERM = true, AFTER_DRAIN = false;
    bf16_t* O; int ldc; const LAS float* rs;
    __device__ __forceinline__ void operator()(const f32x4 (&acc)[2][2][4][2], const Unit& u, int wr, int wc, int fr, int fq) const {
        const int row0 = u.pm * BM + wr * 64 + fr, col0 = u.pn * BM + wc * 32 + 8 * fq;
#pragma unroll
        for (int ai = 0; ai < 2; ++ai)
#pragma unroll
            for (int m = 0; m < 4; ++m) {
                const int ch = row0 + ai * HALF + m * 16, h = ch >> 6, d = ch & 63;
#pragma unroll
                for (int bj = 0; bj < 2; ++bj) {
                    const int tok = col0 + bj * HALF;
                    const LAS f32x4* rp = (const LAS f32x4*)(rs + u.ord * 256 + bj * HALF + wc * 32 + 8 * fq);
                    const f32x4 v0 = acc[ai][bj][m][0] * rp[0], v1 = acc[ai][bj][m][1] * rp[1];
                    u32x4 w; w.x = cvt_pk_bf16(v0[0], v0[1]); w.y = cvt_pk_bf16(v0[2], v0[3]); w.z = cvt_pk_bf16(v1[0], v1[1]); w.w = cvt_pk_bf16(v1[2], v1[3]);
                    *(u32x4*)(O + ((size_t)(tok >> 6) * 8 + h) * 4096 + (d >> 4) * 1024 + ((tok & 63) >> 3) * 128 + (d & 15) * 8) = w;
                }
            }
    }
};
struct EpiOut {
    static constexpr bool PERM = true, AFTER_DRAIN = false;
    const bf16_t* XB; bf16_t* X1B; float* SSP;
    __device__ __forceinline__ void operator()(const f32x4 (&acc)[2][2][4][2], const Unit& u, int wr, int wc, int fr, int fq) const {
        const int row0 = u.pm * BM + wr * 64 + fr, col0 = u.pn * BM + wc * 32 + 8 * fq;
        u32x4 xv[2][2];
#pragma unroll
        for (int bj = 0; bj < 2; ++bj) xv[0][bj] = __builtin_nontemporal_load((const u32x4*)(XB + (size_t)row0 * DM + col0 + bj * HALF));
#pragma unroll
        for (int g = 0; g < 8; ++g) {
            const int ai = g >> 2, m = g & 3;
            if (g < 7) { const int rown = row0 + ((g + 1) >> 2) * HALF + ((g + 1) & 3) * 16;
#pragma unroll
                for (int bj = 0; bj < 2; ++bj) xv[(g + 1) & 1][bj] = __builtin_nontemporal_load((const u32x4*)(XB + (size_t)rown * DM + col0 + bj * HALF)); }
            asm volatile("" ::: "memory");
            const int row = row0 + ai * HALF + m * 16; const size_t off = (size_t)row * DM + col0; float ss = 0.f;
#pragma unroll
            for (int bj = 0; bj < 2; ++bj) {
                const u32x4 t = xv[g & 1][bj];
                const f32x4 v0 = (f32x4){bf_lo(t.x), bf_hi(t.x), bf_lo(t.y), bf_hi(t.y)} + acc[ai][bj][m][0], v1 = (f32x4){bf_lo(t.z), bf_hi(t.z), bf_lo(t.w), bf_hi(t.w)} + acc[ai][bj][m][1];
                u32x4 w; w.x = cvt_pk_bf16(v0[0], v0[1]); w.y = cvt_pk_bf16(v0[2], v0[3]); w.z = cvt_pk_bf16(v1[0], v1[1]); w.w = cvt_pk_bf16(v1[2], v1[3]);
                *(u32x4*)(X1B + off + bj * HALF) = w;
                ss += ((v0[0] * v0[0] + v0[1] * v0[1]) + (v0[2] * v0[2] + v0[3] * v0[3])) + ((v1[0] * v1[0] + v1[1] * v1[1]) + (v1[2] * v1[2] + v1[3] * v1[3]));
            }
            ss += __shfl_xor(ss, 16); ss += __shfl_xor(ss, 32);
            if (fq == 0) SSP[(size_t)row * 16 + u.pn * 4 + wc] = ss;
            asm volatile("" ::: "memory");
        }
    }
};
template <int MODE> struct EpiGUT {
    static constexpr bool PERM = true, AFTER_DRAIN = false;
    const float* SSP; bf16_t* HID; const LAS float* tab;
    __device__ __forceinline__ void operator()(const f32x4 (&acc)[2][2][4][2], const Unit& u, int wr, int wc, int fr, int fq) const {
        const int row0 = u.pm * BM + wr * 64 + fr, col0 = u.pn * 128 + wc * 32 + 8 * fq;
        if (MODE == 1) return;
        if (MODE == 2) {
#pragma unroll
            for (int ai = 0; ai < 2; ++ai)
#pragma unroll
                for (int m = 0; m < 4; ++m) { const f32x4 v0 = acc[ai][0][m][0] + acc[ai][1][m][0], v1 = acc[ai][0][m][1] + acc[ai][1][m][1];
                    u32x4 w; w.x = cvt_pk_bf16(v0[0], v0[1]); w.y = cvt_pk_bf16(v0[2], v0[3]); w.z = cvt_pk_bf16(v1[0], v1[1]); w.w = cvt_pk_bf16(v1[2], v1[3]);
                    *(u32x4*)(HID + (size_t)(row0 + ai * HALF + m * 16) * DFF + col0) = w; }
            return;
        }
        float rstdv[8];
        if (tab) {
#pragma unroll
            for (int g = 0; g < 8; ++g) rstdv[g] = tab[u.ord * 256 + wr * 64 + fr + (g >> 2) * HALF + (g & 3) * 16];
        } else {
            f32x4 s4[8];
#pragma unroll
            for (int g = 0; g < 8; ++g) s4[g] = *(const f32x4*)(SSP + (size_t)(row0 + (g >> 2) * HALF + (g & 3) * 16) * 16 + 4 * fq);
#pragma unroll
            for (int g = 0; g < 8; ++g) { float ssum = (s4[g][0] + s4[g][1]) + (s4[g][2] + s4[g][3]); ssum += __shfl_xor(ssum, 16); ssum += __shfl_xor(ssum, 32); rstdv[g] = rsqrtf(ssum * (1.0f / 1024.0f) + EPS); }
        }
        asm volatile("" ::: "memory");
#pragma unroll
        for (int g = 0; g < 8; ++g) {
            const int ai = g >> 2, m = g & 3, row = row0 + ai * HALF + m * 16; const float rstd = rstdv[g];
            const float c1 = -1.44269504f * rstd, ir2 = __builtin_amdgcn_rcpf(rstd * rstd);
            float v[8];
#pragma unroll
            for (int n = 0; n < 2; ++n)
#pragma unroll
                for (int j = 0; j < 4; ++j) { const float G_ = acc[ai][0][m][n][j], U_ = acc[ai][1][m][n][j];
                    const float t = __builtin_amdgcn_exp2f(c1 * G_); v[n * 4 + j] = (G_ * U_) * __builtin_amdgcn_rcpf(__builtin_fmaf(ir2, t, ir2)); }
            u32x4 w; w.x = cvt_pk_bf16(v[0], v[1]); w.y = cvt_pk_bf16(v[2], v[3]); w.z = cvt_pk_bf16(v[4], v[5]); w.w = cvt_pk_bf16(v[6], v[7]);
            __builtin_nontemporal_store(w, (u32x4*)(HID + (size_t)row * DFF + col0));
        }
    }
};
typedef EpiGUT<0> EpiGU;
struct EpiDown {
    static constexpr bool PERM = true, AFTER_DRAIN = false;
    const bf16_t* X1B; float* OUT;
    __device__ __forceinline__ void operator()(const f32x4 (&acc)[2][2][4][2], const Unit& u, int wr, int wc, int fr, int fq) const {
        const int row0 = u.pm * BM + wr * 64 + fr, col0 = u.pn * BM + wc * 32 + 8 * fq;
        u32x4 xb[2][2];
#pragma unroll
        for (int bj = 0; bj < 2; ++bj) xb[0][bj] = __builtin_nontemporal_load((const u32x4*)(X1B + (size_t)row0 * DM + col0 + bj * HALF));
#pragma unroll
        for (int g = 0; g < 8; ++g) {
            const int ai = g >> 2, m = g & 3;
            if (g < 7) { const int rown = row0 + ((g + 1) >> 2) * HALF + ((g + 1) & 3) * 16;
#pragma unroll
                for (int bj = 0; bj < 2; ++bj) xb[(g + 1) & 1][bj] = __builtin_nontemporal_load((const u32x4*)(X1B + (size_t)rown * DM + col0 + bj * HALF)); }
            asm volatile("" ::: "memory");
            const size_t off = (size_t)(row0 + ai * HALF + m * 16) * DM + col0;
#pragma unroll
            for (int bj = 0; bj < 2; ++bj) { const u32x4 t = xb[g & 1][bj];
                __builtin_nontemporal_store((f32x4){bf_lo(t.x), bf_hi(t.x), bf_lo(t.y), bf_hi(t.y)} + acc[ai][bj][m][0], (f32x4*)(OUT + off + bj * HALF));
                __builtin_nontemporal_store((f32x4){bf_lo(t.z), bf_hi(t.z), bf_lo(t.w), bf_hi(t.w)} + acc[ai][bj][m][1], (f32x4*)(OUT + off + bj * HALF + 4)); }
            asm volatile("" ::: "memory");
        }
    }
};

struct EpiSumOnly {
    static constexpr bool PERM = false, AFTER_DRAIN = false;
    float* DUMP;
    __device__ __forceinline__ void operator()(const f32x4 (&acc)[2][2][4][2], const Unit& u, int wr, int wc, int fr, int fq) const {
        f32x4 t = (f32x4){0.f, 0.f, 0.f, 0.f};
#pragma unroll
        for (int ai = 0; ai < 2; ++ai)
#pragma unroll
            for (int bj = 0; bj < 2; ++bj)
#pragma unroll
                for (int m = 0; m < 4; ++m)
#pragma unroll
                    for (int n = 0; n < 2; ++n) t += acc[ai][bj][m][n];
        DUMP[(size_t)blockIdx.x * 512 + threadIdx.x] = (t[0] + t[1]) + (t[2] + t[3]);
    }
};

struct RevOrder : StaticOrder {
    int R;
    __device__ void init_rev(int M, int N, int G_, int c_) { init(M, N, G_, c_); R = (nwg + G_ - 1) / G_; }
    __device__ bool next(int i, Unit& u) const { if (i >= R) return false; return StaticOrder::next(R - 1 - i, u); }
};

struct InOrder {
    StaticOrder s1, s2;
    __device__ void init(int G_, int c_) { s1.init(NTOK, 2048, G_, c_); s2.init(DATT, NTOK, G_, c_); }
    __device__ bool next(int i, Unit& u) const {
        const long L = (long)i * s1.G + s1.c;
        if (L < s1.nwg) { s1.map((int)L, u); u.ord = i; return true; }
        if (L < s1.nwg + s2.nwg) { s2.map((int)(L - s1.nwg), u); u.alt = 1; u.ord = i; return true; }
        return false;
    }
    __device__ __forceinline__ void a_ready(const Unit&) const {}
    __device__ __forceinline__ void done(const Unit&) const {}
};
struct EpiInAll {
    static constexpr bool PERM = true, AFTER_DRAIN = false;
    EpiIn e1; EpiPlainBf16 e2;
    __device__ __forceinline__ void operator()(const f32x4 (&acc)[2][2][4][2], const Unit& u, int wr, int wc, int fr, int fq) const {
        if (u.alt) e2(acc, u, wr, wc, fr, fq); else e1(acc, u, wr, wc, fr, fq);
    }
};

struct OrdOrder : StaticOrder {
    __device__ bool next(int i, Unit& u) const { const bool ok = StaticOrder::next(i, u); u.ord = i; return ok; }
};
constexpr int RSTAB_OFF = RPB_OFF;
constexpr int RSTAB_MAX_ROUNDS = (8 * 15 * 64 * 4) / 1024;
constexpr int QKG_OFF = RPB_OFF;
constexpr int RS1TAB_OFF = RPB_OFF + 1024;
__device__ __forceinline__ int win_src_col(int nd) {
    if (nd < 1024) { const int pn = nd >> 8, bj = (nd >> 7) & 1, x = nd & 127; return bj * 512 + pn * 128 + x; }
    if (nd < 2048) { const int e = nd - 1024, pn4 = e >> 8, w = e & 255, bj = w >> 7, wc = (w >> 5) & 3, x = w & 31; return 1024 + pn4 * 256 + wc * 64 + bj * 32 + x; }
    return nd;
}
__device__ __forceinline__ void wt_item(const float* __restrict__ W, int Nsrc, int sc, bf16_t* __restrict__ Wt, int K, int n, int k0, const float* __restrict__ g) {
    float v[32];
    const float* wp = W + (size_t)k0 * Nsrc + sc;
#pragma unroll
    for (int q = 0; q < 32; ++q) v[q] = wp[(size_t)q * Nsrc];
    if (g) {
#pragma unroll
        for (int q = 0; q < 32; q += 4) { const f32x4 gv = *(const f32x4*)(g + k0 + q); v[q] *= gv[0]; v[q + 1] *= gv[1]; v[q + 2] *= gv[2]; v[q + 3] *= gv[3]; }
    }
    bf16_t* op = Wt + (size_t)n * K + k0;
#pragma unroll
    for (int q = 0; q < 32; q += 8) { u32x4 w; w.x = cvt_pk_bf16(v[q], v[q + 1]); w.y = cvt_pk_bf16(v[q + 2], v[q + 3]); w.z = cvt_pk_bf16(v[q + 4], v[q + 5]); w.w = cvt_pk_bf16(v[q + 6], v[q + 7]); *(u32x4*)(op + q) = w; }
}
__device__ __forceinline__ void phase0(const Params& p, LAS unsigned char* lds, int tid, int wid, int lane) {
    bf16_t* Win_t = (bf16_t*)(p.ws + WS_WIN); bf16_t* Wout_t = (bf16_t*)(p.ws + WS_WOUT); bf16_t* Wgu_t = (bf16_t*)(p.ws + WS_WGU); bf16_t* Wd_t = (bf16_t*)(p.ws + WS_WD);
    constexpr int T_IN = 40 * 32, T_OUT = 16 * 32, T_GU = 88 * 32, T_D = 16 * 88, T_ALL = T_IN + T_OUT + T_GU + T_D;
    const int gw = blockIdx.x * 8 + wid, nw = gridDim.x * 8;
    for (int t = gw; t < T_ALL; t += nw) {
        if (t < T_IN) { const int nt = t >> 5, kt = t & 31, nd = nt * 64 + lane; wt_item(p.w_in, DIN, win_src_col(nd), Win_t, DM, nd, kt * 32, p.norm1_g); }
        else if (t < T_IN + T_OUT) { const int e = t - T_IN, nt = e >> 5, kt = e & 31, nd = nt * 64 + lane; wt_item(p.w_out, DM, nd, Wout_t, DM, nd, kt * 32, nullptr); }
        else if (t < T_IN + T_OUT + T_GU) { const int e = t - T_IN - T_OUT, nt = e >> 5, kt = e & 31; const int nd = nt * 64 + lane, pn = nd >> 8, bj = (nd >> 7) & 1, x = nd & 127;
            wt_item(bj ? p.w_up : p.w_gate, DFF, pn * 128 + x, Wgu_t, DM, nd, kt * 32, p.norm2_g); }
        else { const int e = t - T_IN - T_OUT - T_GU, nt = e / 88, kt = e % 88, nd = nt * 64 + lane; wt_item(p.w_down, DM, nd, Wd_t, DFF, nd, kt * 32, nullptr); }
    }
    bf16_t* XB = (bf16_t*)(p.ws + WS_H1); float* RS1 = (float*)(p.ws + WS_RS1);
    for (int row = gw * 2; row < NTOK; row += nw * 2) {
        f32x4 a[2][4];
#pragma unroll
        for (int rr = 0; rr < 2; ++rr) { const float* xr = p.x + (size_t)(row + rr) * DM + lane * 8; a[rr][0] = __builtin_nontemporal_load((const f32x4*)xr); a[rr][1] = __builtin_nontemporal_load((const f32x4*)(xr + 4)); a[rr][2] = __builtin_nontemporal_load((const f32x4*)(xr + 512)); a[rr][3] = __builtin_nontemporal_load((const f32x4*)(xr + 516)); }
#pragma unroll
        for (int rr = 0; rr < 2; ++rr) {
            float ss = 0.f;
#pragma unroll
            for (int q = 0; q < 4; ++q) ss += a[rr][0][q] * a[rr][0][q] + a[rr][1][q] * a[rr][1][q] + a[rr][2][q] * a[rr][2][q] + a[rr][3][q] * a[rr][3][q];
#pragma unroll
            for (int o = 1; o < 64; o <<= 1) ss += __shfl_xor(ss, o);
            if (lane == 0) RS1[row + rr] = rsqrtf(ss * (1.0f / 1024.0f) + EPS);
            const f32x4 b0 = a[rr][0], b1 = a[rr][1], b2 = a[rr][2], b3 = a[rr][3];
            u32x4 w0, w1; w0.x = cvt_pk_bf16(b0[0], b0[1]); w0.y = cvt_pk_bf16(b0[2], b0[3]); w0.z = cvt_pk_bf16(b1[0], b1[1]); w0.w = cvt_pk_bf16(b1[2], b1[3]);
            w1.x = cvt_pk_bf16(b2[0], b2[1]); w1.y = cvt_pk_bf16(b2[2], b2[3]); w1.z = cvt_pk_bf16(b3[0], b3[1]); w1.w = cvt_pk_bf16(b3[2], b3[3]);
            bf16_t* hr = XB + (size_t)(row + rr) * DM + lane * 8;
            *(u32x4*)hr = w0; *(u32x4*)(hr + 512) = w1;
        }
    }
}

constexpr int CT = 32;
constexpr int UB_ROWS = CT + CW - 1;
constexpr int YB_OFF = 63488;
__device__ __forceinline__ void conv_phase(const Params& p, LAS unsigned char* lds, int tid, int wid, int lane) {
    const bf16_t* U = (const bf16_t*)(p.ws + WS_U); bf16_t* MIX = (bf16_t*)(p.ws + WS_MIX);
    const int cp = tid & 255, th = tid >> 8;
    f32x2v wv[CW];
#pragma unroll
    for (int j = 0; j < CW; ++j) wv[j] = *(const f32x2v*)(p.dw_kernel + j * DCONV + 2 * cp);
    const f32x2v cb = *(const f32x2v*)(p.dw_bias + 2 * cp);
    const f32x4 lg0 = *(const f32x4*)(p.conv_ln_g + lane * 8), lg1 = *(const f32x4*)(p.conv_ln_g + lane * 8 + 4);
    const f32x4 lb0 = *(const f32x4*)(p.conv_ln_b + lane * 8), lb1 = *(const f32x4*)(p.conv_ln_b + lane * 8 + 4);
    LAS unsigned char* ub = lds; LAS float* yb = (LAS float*)(lds + YB_OFF);
    const bool x8 = (gridDim.x & 7) == 0;
    const int G8 = x8 ? (int)(gridDim.x >> 3) : (int)gridDim.x, xcd = x8 ? (int)(blockIdx.x & 7) : 0, slot = x8 ? (int)(blockIdx.x >> 3) : (int)blockIdx.x, per_xcd = x8 ? ((NTOK / CT) >> 3) : (NTOK / CT);
    u32x4 pre[8];
#define CONV_FETCH(tile_) do { const int b_ = (tile_) >> 8, t0_ = ((tile_) & 255) * CT; _Pragma("unroll") for (int q_ = 0; q_ < 8; ++q_) { const int idx_ = tid + q_ * NTHREADS, rr_ = idx_ >> 6, cc_ = idx_ & 63, t_ = t0_ - 15 + rr_; \
        pre[q_] = (u32x4){0u, 0u, 0u, 0u}; if (idx_ < UB_ROWS * 64 && t_ >= 0 && t_ < SEQ) pre[q_] = *(const u32x4*)(U + (size_t)(b_ * SEQ + t_) * DCONV + cc_ * 8); } } while (0)
#define CONV_PUT() do { _Pragma("unroll") for (int q_ = 0; q_ < 8; ++q_) { const int idx_ = tid + q_ * NTHREADS; if (idx_ < UB_ROWS * 64) *(LAS u32x4*)(ub + (idx_ >> 6) * 1024 + (idx_ & 63) * 16) = pre[q_]; } } while (0)
    if (slot < per_xcd) { CONV_FETCH(xcd * per_xcd + slot); CONV_PUT(); }
    for (int it = slot; it < per_xcd; it += G8) {
        const int tile = xcd * per_xcd + it;
        const int b = tile >> 8, t0 = (tile & 255) * CT;
        const bool has_next = (it + G8) < per_xcd;
        if (has_next) CONV_FETCH(tile + G8);
        __syncthreads();
#pragma unroll 1
        for (int sub = 0; sub < 2; ++sub) {
            const int base = th * 16 + sub * 8;
            f32x2v av[8];
#pragma unroll
            for (int t = 0; t < 8; ++t) av[t] = cb;
#pragma unroll
            for (int i = 0; i < 8 + CW - 1; ++i) {
                const unsigned uu = *(const LAS unsigned*)(ub + (base + i) * 1024 + cp * 4); const f32x2v u2 = (f32x2v){bf_lo(uu), bf_hi(uu)};
#pragma unroll
                for (int t = 0; t < 8; ++t) { const int j = i - t; if (j >= 0 && j < CW) av[t] = __builtin_elementwise_fma(u2, wv[j], av[t]); }
            }
#pragma unroll
            for (int t = 0; t < 8; ++t) *(LAS f32x2v*)(yb + (base + t) * DCONV + 2 * cp) = av[t];
        }
        __syncthreads();
#pragma unroll
        for (int q = 0; q < 4; ++q) {
            const int tok = wid * 4 + q;
            const f32x4 y0 = *(const LAS f32x4*)(yb + tok * DCONV + lane * 8), y1 = *(const LAS f32x4*)(yb + tok * DCONV + lane * 8 + 4);
            float s = (y0[0] + y0[1]) + (y0[2] + y0[3]) + (y1[0] + y1[1]) + (y1[2] + y1[3]);
#pragma unroll
            for (int o = 1; o < 64; o <<= 1) s += __shfl_xor(s, o);
            const float mu = s * (1.0f / 512.0f);
            const f32x4 d0 = y0 - mu, d1 = y1 - mu;
            float qv = (d0[0] * d0[0] + d0[1] * d0[1]) + (d0[2] * d0[2] + d0[3] * d0[3]) + (d1[0] * d1[0] + d1[1] * d1[1]) + (d1[2] * d1[2] + d1[3] * d1[3]);
#pragma unroll
            for (int o = 1; o < 64; o <<= 1) qv += __shfl_xor(qv, o);
            const float rstd = rsqrtf(qv * (1.0f / 512.0f) + EPS);
            f32x4 z0 = d0 * rstd * lg0 + lb0, z1 = d1 * rstd * lg1 + lb1;
#pragma unroll
            for (int e = 0; e < 4; ++e) { z0[e] = z0[e] * sigmoidf_fast(z0[e]); z1[e] = z1[e] * sigmoidf_fast(z1[e]); }
            u32x4 w; w.x = cvt_pk_bf16(z0[0], z0[1]); w.y = cvt_pk_bf16(z0[2], z0[3]); w.z = cvt_pk_bf16(z1[0], z1[1]); w.w = cvt_pk_bf16(z1[2], z1[3]);
            *(u32x4*)(MIX + (size_t)(b * SEQ + t0 + tok) * DM + lane * 8) = w;
        }
        if (has_next) CONV_PUT();
        __syncthreads();
    }
#undef CONV_FETCH
#undef CONV_PUT
}

__device__ __forceinline__ void attn_phase(const Params& p, LAS unsigned char* lds, int tid, int wid, int lane) {
    const bf16_t* Q = (const bf16_t*)(p.ws + WS_Q); const bf16_t* Kb = (const bf16_t*)(p.ws + WS_K); const bf16_t* VT = (const bf16_t*)(p.ws + WS_VT); bf16_t* MIX = (bf16_t*)(p.ws + WS_MIX);
    const LAS float* rp = (const LAS float*)(lds + RPB_OFF);
    const int fr = lane & 15, fq = lane >> 4, h = wid;
    const bool x8 = (gridDim.x & 7) == 0;
    const int G8 = x8 ? (int)(gridDim.x >> 3) : (int)gridDim.x, xcd = x8 ? (int)(blockIdx.x & 7) : 0, slot = x8 ? (int)(blockIdx.x >> 3) : (int)blockIdx.x, per_xcd = x8 ? ((4 * 128) >> 3) : (4 * 128);
    for (int it = slot; it < per_xcd; it += G8) {
        const int unit = xcd * per_xcd + it;
        const int b = unit >> 7, r = unit & 127;
        const int rs = min(max(r - 4, 0), 120);
        const size_t tokq0 = (size_t)b * SEQ + r * 64;
#pragma unroll 1
        for (int qb = 0; qb < 4; ++qb) {
            const int win = (qb == 0) ? 0 : (qb == 1) ? 8 : (qb == 2) ? 24 : 32;
            const bf16_t* qp = Q + (tokq0 + 16 * qb + fr) * DATT + h * 64 + 8 * fq;
            const bf16x8 qf0 = *(const bf16x8*)qp, qf1 = *(const bf16x8*)(qp + 32);
            f32x4 s[8][2];
            const int w8 = win >> 3;
            const bf16_t* kbase = Kb + ((size_t)(b * 128 + rs) * 8 + h) * 4096 + fq * 512 + w8 * 32 + fr * 8;
            const bf16_t* vbase = VT + ((size_t)(b * 128 + rs) * 8 + h) * 4096 + (w8 + fq) * 128 + fr * 8;
            {
                bf16x8 kf[8][2][2];
#pragma unroll
                for (int i = 0; i < 8; ++i)
#pragma unroll
                    for (int t = 0; t < 2; ++t) { const bf16_t* kp = kbase + i * 32768 + t * 256; kf[i][t][0] = *(const bf16x8*)kp; kf[i][t][1] = *(const bf16x8*)(kp + 2048); }
                __builtin_amdgcn_sched_barrier(0);
                __builtin_amdgcn_s_setprio(1);
#pragma unroll
                for (int i = 0; i < 8; ++i)
#pragma unroll
                    for (int t = 0; t < 2; ++t) {
                        f32x4 z = (f32x4){0.f, 0.f, 0.f, 0.f};
                        z = __builtin_amdgcn_mfma_f32_16x16x32_bf16(kf[i][t][0], qf0, z, 0, 0, 0);
                        s[i][t] = __builtin_amdgcn_mfma_f32_16x16x32_bf16(kf[i][t][1], qf1, z, 0, 0, 0);
                    }
                __builtin_amdgcn_s_setprio(0);
            }
            bf16x8 vf[4][4];
#pragma unroll
            for (int i = 0; i < 4; ++i)
#pragma unroll
                for (int dt = 0; dt < 4; ++dt) vf[i][dt] = *(const bf16x8*)(vbase + i * 32768 + dt * 1024);
            __builtin_amdgcn_sched_barrier(0);
            const int c = 16 * qb + fr, cs = min(max(c - 8, 0), 48);
            const LAS float* rph = rp + h * (15 * 64) + (rs - r + 7) * 64 + (win + 8 * fq - c + 15 + 16);
            float bv[8][2][4];
#pragma unroll
            for (int i = 0; i < 8; ++i)
#pragma unroll
                for (int t = 0; t < 2; ++t)
#pragma unroll
                    for (int j = 0; j < 4; ++j) bv[i][t][j] = rph[i * 64 + 4 * t + j];
            float mx = -1e30f;
#pragma unroll
            for (int i = 0; i < 8; ++i)
#pragma unroll
                for (int t = 0; t < 2; ++t)
#pragma unroll
                    for (int j = 0; j < 4; ++j) {
                        const int kcol = win + 8 * fq + 4 * t + j; const bool valid = (kcol >= cs) && (kcol < cs + 16);
                        const float v = valid ? s[i][t][j] + bv[i][t][j] : -1e30f;
                        s[i][t][j] = v; mx = fmaxf(mx, v);
                    }
            mx = fmaxf(mx, __shfl_xor(mx, 16)); mx = fmaxf(mx, __shfl_xor(mx, 32));
            float sum = 0.f;
#pragma unroll
            for (int i = 0; i < 8; ++i)
#pragma unroll
                for (int t = 0; t < 2; ++t)
#pragma unroll
                    for (int j = 0; j < 4; ++j) { const float e = __expf(s[i][t][j] - mx); s[i][t][j] = e; sum += e; }
            sum += __shfl_xor(sum, 16); sum += __shfl_xor(sum, 32);
            f32x4 o[4];
#pragma unroll
            for (int dt = 0; dt < 4; ++dt) o[dt] = (f32x4){0.f, 0.f, 0.f, 0.f};
            bf16x8 vg[4][4];
#pragma unroll
            for (int i = 0; i < 4; ++i)
#pragma unroll
                for (int dt = 0; dt < 4; ++dt) vg[i][dt] = *(const bf16x8*)(vbase + (i + 4) * 32768 + dt * 1024);
            __builtin_amdgcn_sched_barrier(0);
            __builtin_amdgcn_s_setprio(1);
#pragma unroll
            for (int i = 0; i < 8; ++i) {
                u32x4 pw; pw.x = cvt_pk_bf16(s[i][0][0], s[i][0][1]); pw.y = cvt_pk_bf16(s[i][0][2], s[i][0][3]); pw.z = cvt_pk_bf16(s[i][1][0], s[i][1][1]); pw.w = cvt_pk_bf16(s[i][1][2], s[i][1][3]);
                const bf16x8 pb = __builtin_bit_cast(bf16x8, pw);
#pragma unroll
                for (int dt = 0; dt < 4; ++dt) o[dt] = __builtin_amdgcn_mfma_f32_16x16x32_bf16(i < 4 ? vf[i & 3][dt] : vg[i & 3][dt], pb, o[dt], 0, 0, 0);
            }
            __builtin_amdgcn_s_setprio(0);
            const float inv = 1.0f / sum;
            bf16_t* op = MIX + (tokq0 + 16 * qb + fr) * DM + DCONV + h * 64 + 4 * fq;
#pragma unroll
            for (int dt = 0; dt < 4; ++dt) { uint2 w; w.x = cvt_pk_bf16(o[dt][0] * inv, o[dt][1] * inv); w.y = cvt_pk_bf16(o[dt][2] * inv, o[dt][3] * inv); *(uint2*)(op + 16 * dt) = w; }
        }
    }
}


__device__ __forceinline__ void stagger_start(int group, int ticks) {
    if (group > 0) { const unsigned long long t0 = __builtin_amdgcn_s_memrealtime(), want = (unsigned long long)(group * ticks);
        while (__builtin_amdgcn_s_memrealtime() - t0 < want) __builtin_amdgcn_s_sleep(16); }
}
#ifndef STAG4
#define STAG4 160
#endif
__global__ void __launch_bounds__(NTHREADS, 2) fwd_megakernel(Params p) {
    extern __shared__ __attribute__((aligned(16))) unsigned char lds_raw[];
    LAS unsigned char* lds = (LAS unsigned char*)lds_raw;
    const int tid = threadIdx.x, wid = __builtin_amdgcn_readfirstlane(tid >> 6), lane = tid & 63;
    const int lo = p.ph_lo, hi = p.ph_hi, G = gridDim.x, c = blockIdx.x;
    unsigned char* ws = p.ws;
#define IN(k) (lo <= (k) && (k) < hi)
#ifndef PROBE_REPEAT
#define PROBE_REPEAT -1
#endif
#define REP(k) for (int rep_ = 0; rep_ < ((PROBE_REPEAT == (k)) ? 2 : 1); ++rep_)
#define SEAM(k) do { if (IN(k) && IN((k) + 1)) xcd_barrier(bar); } while (0)
    if (lo > hi) cg::this_grid().sync();
    XcdBarrier bar; bar.bar = (unsigned*)(ws + WS_BAR); bar.x = 0; bar.st = nullptr;
    if (hi - lo > 1) {
        if (tid < 4) ((LAS unsigned*)(lds + BARLDS_OFF))[tid] = 0u;
        __syncthreads();
        bar = xcd_barrier_post((unsigned*)(ws + WS_BAR), (volatile LAS unsigned*)(lds + BARLDS_OFF));
    }
    if (IN(0)) REP(0) phase0(p, lds, tid, wid, lane);
    SEAM(0);
#if defined(PROBE_SYNCS)
    for (int q_ = 0; q_ < PROBE_SYNCS; ++q_) xcd_barrier(bar);
#endif
    if (IN(1)) REP(1) {
        Gemm g{(const bf16_t*)(ws + WS_H1), (const bf16_t*)(ws + WS_WIN), NTOK, 2048, DM, (const bf16_t*)(ws + WS_WIN) + (size_t)2048 * DM, (const bf16_t*)(ws + WS_H1)};
        InOrder S; S.init(G, c);
        LAS float* gl = (LAS float*)(lds + QKG_OFF); LAS float* rs = (LAS float*)(lds + RS1TAB_OFF);
        if (tid < 128) gl[tid] = tid < 64 ? p.q_norm_g[tid] : p.k_norm_g[tid - 64];
        {
            const int rounds1 = (S.s1.nwg + S.s2.nwg + G - 1) / G;
            for (int e = tid; e < rounds1 * 256 && e < 29 * 256; e += NTHREADS) { Unit uu; if (S.next(e >> 8, uu)) rs[e] = ((const float*)(ws + WS_RS1))[(uu.alt ? uu.pn : uu.pm) * BM + (e & 255)]; }
        }
        __syncthreads();
        EpiInAll E{EpiIn{(bf16_t*)(ws + WS_U), (bf16_t*)(ws + WS_Q), (bf16_t*)(ws + WS_K), gl, rs}, EpiPlainBf16{(bf16_t*)(ws + WS_VT), NTOK, rs}};
#if defined(PROBE_KLOOP) && PROBE_KLOOP == 1
        { EpiSumOnly E2{(float*)(ws + WS_BAR + 16384)}; gemm_phase<EpiSumOnly, InOrder, false>(lds, g, S, E2, nullptr); }
#endif
        gemm_phase<EpiInAll, InOrder, false>(lds, g, S, E, nullptr);
    }
    SEAM(1);
    if (IN(2)) REP(2) {
        for (int i = tid; i < NH * 15 * 64; i += NTHREADS) { const int ci = (i & 63) - 16; ((LAS float*)(lds + RPB_OFF))[i] = (ci >= 0 && ci < 31) ? p.rpb[(i >> 6) * 31 + ci] : 0.f; }
        __syncthreads();
        REP(21) attn_phase(p, lds, tid, wid, lane);
        REP(20) conv_phase(p, lds, tid, wid, lane);
    }
    SEAM(2);
    if (IN(3)) REP(3) {
        Gemm g{(const bf16_t*)(ws + WS_MIX), (const bf16_t*)(ws + WS_WOUT), NTOK, DM, DM}; StaticOrder S; S.init(NTOK, DM, G, c);
        EpiOut E{(const bf16_t*)(ws + WS_H1), (bf16_t*)(ws + WS_H1), (float*)(ws + WS_SSP)};
        gemm_phase<EpiOut, StaticOrder, false>(lds, g, S, E, nullptr);
    }
    SEAM(3);
    if (IN(4)) REP(4) {
        Gemm g{(const bf16_t*)(ws + WS_H1), (const bf16_t*)(ws + WS_WGU), NTOK, 2 * DFF, DM}; OrdOrder S; S.init(NTOK, 2 * DFF, G, c);
        const int rounds = (S.nwg + G - 1) / G;
        LAS float* tab = (LAS float*)(lds + RSTAB_OFF);
        const bool use_tab = rounds <= RSTAB_MAX_ROUNDS;
        if (use_tab) {
            for (int e = tid; e < rounds * 256; e += NTHREADS) {
                Unit uu; const int i = e >> 8;
                if (S.next(i, uu)) { const f32x4* sp = (const f32x4*)((const float*)(ws + WS_SSP) + (size_t)(uu.pm * BM + (e & 255)) * 16);
                    const f32x4 s4 = (sp[0] + sp[1]) + (sp[2] + sp[3]); tab[e] = rsqrtf(((s4[0] + s4[1]) + (s4[2] + s4[3])) * (1.0f / 1024.0f) + EPS); }
            }
            __syncthreads();
        }
        EpiGU E{(const float*)(ws + WS_SSP), (bf16_t*)(ws + WS_HID), use_tab ? tab : nullptr};
#if defined(STAG4G)
        stagger_start((c >> 3) % STAG4G, STAG4T);
#endif
#if defined(PROBE_KLOOP) && PROBE_KLOOP == 4
        { EpiSumOnly E2{(float*)(ws + WS_BAR + 16384)}; gemm_phase<EpiSumOnly, OrdOrder, false>(lds, g, S, E2, nullptr); }
#endif
#if defined(PROBE_GU_MODE)
        { EpiGUT<PROBE_GU_MODE> E2{(const float*)(ws + WS_SSP), (bf16_t*)(ws + WS_HID), nullptr}; gemm_phase<EpiGUT<PROBE_GU_MODE>, OrdOrder, false>(lds, g, S, E2, nullptr); }
#endif
        gemm_phase<EpiGU, OrdOrder, false>(lds, g, S, E, nullptr);
    }
    SEAM(4);
    if (IN(5)) REP(5) {
        Gemm g{(const bf16_t*)(ws + WS_HID), (const bf16_t*)(ws + WS_WD), NTOK, DM, DFF}; RevOrder S; S.init_rev(NTOK, DM, G, c);
        EpiDown E{(const bf16_t*)(ws + WS_H1), p.out};
#if defined(PROBE_KLOOP) && PROBE_KLOOP == 5
        { EpiSumOnly E2{(float*)(ws + WS_BAR + 16384)}; gemm_phase<EpiSumOnly, RevOrder, false>(lds, g, S, E2, nullptr); }
#endif
#if defined(STAG5)
        stagger_start((c >> 3) & 7, STAG5);
#endif
        gemm_phase<EpiDown, RevOrder, false>(lds, g, S, E, nullptr);
    }
#undef IN
#undef SEAM
}

#ifndef N_LAUNCHES
#define N_LAUNCHES 1
#endif
extern "C" void kernel_launch(void* const* d_in, const int* in_sizes, int n_in, void* d_out, int out_size, void* d_ws, size_t ws_size, hipStream_t stream) {
    static int grid = 0;
    if (grid == 0) {
        if (ws_size < WS_END) { fprintf(stderr, "kernel_launch: workspace too small: %zu < %zu\n", ws_size, (size_t)WS_END); grid = -1; return; }
        int dev = 0, cus = 0, per_cu = 0;
        (void)hipGetDevice(&dev); (void)hipDeviceGetAttribute(&cus, hipDeviceAttributeMultiprocessorCount, dev);
        if (hipFuncSetAttribute((const void*)fwd_megakernel, hipFuncAttributeMaxDynamicSharedMemorySize, LDS_BYTES) != hipSuccess) { fprintf(stderr, "kernel_launch: hipFuncSetAttribute failed\n"); grid = -1; return; }
        if (hipOccupancyMaxActiveBlocksPerMultiprocessor(&per_cu, (const void*)fwd_megakernel, NTHREADS, LDS_BYTES) != hipSuccess || per_cu < 1) { fprintf(stderr, "kernel_launch: occupancy query says %d\n", per_cu); per_cu = 1; }
        (void)hipGetLastError();
        grid = cus * 1;
    }
    if (grid < 0) return;
    Params p{};
    p.x = (const float*)d_in[0]; p.norm1_g = (const float*)d_in[1]; p.w_in = (const float*)d_in[2]; p.q_norm_g = (const float*)d_in[3]; p.k_norm_g = (const float*)d_in[4];
    p.rpb = (const float*)d_in[5]; p.dw_kernel = (const float*)d_in[6]; p.dw_bias = (const float*)d_in[7]; p.conv_ln_g = (const float*)d_in[8]; p.conv_ln_b = (const float*)d_in[9];
    p.w_out = (const float*)d_in[10]; p.norm2_g = (const float*)d_in[11]; p.w_gate = (const float*)d_in[12]; p.w_up = (const float*)d_in[13]; p.w_down = (const float*)d_in[14];
    p.out = (float*)d_out; p.ws = (unsigned char*)d_ws;
#if N_LAUNCHES == 1
    p.ph_lo = 0; p.ph_hi = 6;
#if defined(PROBE_MEMSET)
    for (int q_ = 0; q_ < PROBE_MEMSET; ++q_) (void)hipMemsetAsync((char*)d_ws + WS_BAR + 16384 + 256 * 512 * 4, 0, 16384, stream);
#endif
    if (hipMemsetAsync((char*)d_ws + WS_BAR, 0, 16384, stream) != hipSuccess) { fprintf(stderr, "kernel_launch: hipMemsetAsync failed\n"); return; }
    void* args[] = {&p};
    hipError_t e = hipLaunchCooperativeKernel((const void*)fwd_megakernel, dim3(grid), dim3(NTHREADS), args, LDS_BYTES, stream);
    if (e != hipSuccess) fprintf(stderr, "cooperative launch failed: %s (grid %d)\n", hipGetErrorString(e), grid);
#else
    for (int ph = 0; ph < 6; ++ph) { p.ph_lo = ph; p.ph_hi = ph + 1; hipLaunchKernelGGL(fwd_megakernel, dim3(grid), dim3(NTHREADS), LDS_BYTES, stream, p); }
#endif
}
```
